# Optimizing an MI355X kernel written in HIP

```python
import jax
import jax.numpy as jnp
from jax import lax
import numpy as np


D_MODEL = 1024
BATCH = 8
SEQ = 2048
DEPTH = 2

RMS_EPS = 1e-6
SSD_WIDTH = D_MODEL
SSD_HEAD_DIM = 64
SSD_HEADS = SSD_WIDTH // SSD_HEAD_DIM
SSD_GROUPS = 2
SSD_HEADS_PER_GROUP = SSD_HEADS // SSD_GROUPS
SSD_STATE = 64
SSD_CONV = 4
SSD_CHUNK = 128
SSD_CONV_DIM = SSD_WIDTH + 2 * SSD_GROUPS * SSD_STATE
GLA_HEADS = 8
GLA_VALUE_WIDTH = D_MODEL
GLA_KEY_WIDTH = D_MODEL // 2
GLA_HEAD_K = GLA_KEY_WIDTH // GLA_HEADS
GLA_HEAD_V = GLA_VALUE_WIDTH // GLA_HEADS
GLA_GATE_RANK = 16
GLA_GATE_NORMALIZER = 16.0
GLA_CHUNK = 64
EVEN_SPLITS = (SSD_WIDTH, SSD_CONV_DIM, SSD_HEADS, GLA_KEY_WIDTH, GLA_KEY_WIDTH, GLA_VALUE_WIDTH, GLA_GATE_RANK, GLA_VALUE_WIDTH)
EVEN_IN_WIDTH = sum(EVEN_SPLITS)
EVEN_MIX_WIDTH = SSD_WIDTH + GLA_VALUE_WIDTH
MOBA_HEADS = 16
MOBA_HEAD_DIM = 64
MOBA_WIDTH = MOBA_HEADS * MOBA_HEAD_DIM
MOBA_BLOCK = 256
MOBA_TOPK = 3
MOBA_Q_CHUNK = 32
ODD_IN_WIDTH = 4 * MOBA_WIDTH
N_EVEN = (DEPTH + 1) // 2
N_ODD = DEPTH // 2

kernel_name = 'hybrid_ssd_gla_moba_trunk'


def rms_norm(x, w):
    x32 = x.astype(jnp.float32)
    y = x32 * lax.rsqrt(jnp.mean(x32 * x32, axis=-1, keepdims=True) + RMS_EPS)
    return y * w.astype(jnp.float32)


def split_cols(u, sizes):
    cuts = [int(c) for c in np.cumsum(sizes)[:-1]]
    return jnp.split(u, cuts, axis=-1)


def causal_depthwise_conv(u, w, b):
    k_width = w.shape[0]
    y = lax.conv_general_dilated(u, w.astype(u.dtype)[:, None, :], window_strides=(1,), padding=[(k_width - 1, 0)], dimension_numbers=('NWC', 'WIO', 'NWC'), feature_group_count=u.shape[-1])
    return y + b.astype(u.dtype)


def ssd_chunked_scan(xs, dt, a, bm, cm, d_skip):
    b, L, G, E, P = xs.shape
    N = bm.shape[-1]
    Q = SSD_CHUNK
    nc = L // Q
    x_c = xs.reshape(b, nc, Q, G, E, P)
    dt_c = dt.reshape(b, nc, Q, G, E)
    xdt = x_c * dt_c[..., None]
    b_c = bm.reshape(b, nc, Q, G, N)
    c_c = cm.reshape(b, nc, Q, G, N)
    a_cs = jnp.cumsum(dt_c * a, axis=2)
    a_t = jnp.moveaxis(a_cs, 2, -1)
    seg = a_t[..., :, None] - a_t[..., None, :]
    causal = jnp.tril(jnp.ones((Q, Q), dtype=bool))
    decay_ij = jnp.exp(jnp.where(causal, seg, -jnp.inf))
    cb = jnp.einsum('bcign,bcjgn->bcgij', c_c, b_c)
    y_diag = jnp.einsum('bcgeij,bcjgep->bcigep', cb[:, :, :, None] * decay_ij, xdt)
    a_last = a_cs[:, :, -1]
    decay_to_end = jnp.exp(a_last[:, :, None] - a_cs)
    chunk_states = jnp.einsum('bcjgn,bcjge,bcjgep->bcgepn', b_c, decay_to_end, xdt)

    def carry_state(h, inp):
        chunk_decay, s = inp
        return chunk_decay[..., None, None] * h + s, h

    _, prev_states = lax.scan(carry_state, jnp.zeros_like(chunk_states[:, 0]), (jnp.moveaxis(jnp.exp(a_last), 1, 0), jnp.moveaxis(chunk_states, 1, 0)))
    prev_states = jnp.moveaxis(prev_states, 0, 1)
    y_off = jnp.einsum('bcign,bcgepn->bcigep', c_c, prev_states) * jnp.exp(a_cs)[..., None]
    y = y_diag + y_off + d_skip[:, :, None] * x_c
    return y.reshape(b, L, G * E * P)


def gla_chunked(q, k, v, log_decay):
    b, L, H, dk = q.shape
    dv = v.shape[-1]
    C = GLA_CHUNK
    n = L // C
    q = q.reshape(b, n, C, H, dk)
    k = k.reshape(b, n, C, H, dk)
    v = v.reshape(b, n, C, H, dv)
    gcs = jnp.cumsum(log_decay.reshape(b, n, C, H, dk), axis=2)
    ref = gcs[:, :, C // 2:C // 2 + 1]
    scores = jnp.einsum('bnihd,bnjhd->bnhij', q * jnp.exp(gcs - ref), k * jnp.exp(ref - gcs))
    causal = jnp.tril(jnp.ones((C, C), dtype=bool))
    scores = jnp.where(causal, scores, 0.0)
    o_intra = jnp.einsum('bnhij,bnjhv->bnihv', scores, v)
    g_last = gcs[:, :, -1]
    chunk_kv = jnp.einsum('bnjhd,bnjhv->bnhdv', k * jnp.exp(g_last[:, :, None] - gcs), v)

    def carry_state(s, inp):
        decay, kv = inp
        return decay[..., None] * s + kv, s

    _, prev_states = lax.scan(carry_state, jnp.zeros_like(chunk_kv[:, 0]), (jnp.moveaxis(jnp.exp(g_last), 1, 0), jnp.moveaxis(chunk_kv, 1, 0)))
    prev_states = jnp.moveaxis(prev_states, 0, 1)
    o_inter = jnp.einsum('bnihd,bnhdv->bnihv', q * jnp.exp(gcs), prev_states)
    return (o_intra + o_inter).reshape(b, L, H, dv)


def ssd_gla_layer(x, norm_w, w_in, conv_w, conv_b, a_log, dt_bias, d_skip, ssd_norm_w, gate_w2, gate_b, gla_norm_w, w_out):
    bsz, L, _ = x.shape
    h = rms_norm(x, norm_w)
    u = h @ w_in.astype(jnp.float32)
    z_a, xbc, dt_raw, q_b, k_b, v_b, gate_lr, g_b = split_cols(u, EVEN_SPLITS)
    xbc = jax.nn.silu(causal_depthwise_conv(xbc, conv_w, conv_b))
    xs, bm, cm = split_cols(xbc, (SSD_WIDTH, SSD_GROUPS * SSD_STATE, SSD_GROUPS * SSD_STATE))
    xs = xs.reshape(bsz, L, SSD_GROUPS, SSD_HEADS_PER_GROUP, SSD_HEAD_DIM)
    bm = bm.reshape(bsz, L, SSD_GROUPS, SSD_STATE)
    cm = cm.reshape(bsz, L, SSD_GROUPS, SSD_STATE)
    dt = jax.nn.softplus(dt_raw + dt_bias.astype(jnp.float32)).reshape(bsz, L, SSD_GROUPS, SSD_HEADS_PER_GROUP)
    a = -jnp.exp(a_log.astype(jnp.float32)).reshape(SSD_GROUPS, SSD_HEADS_PER_GROUP)
    d = d_skip.astype(jnp.float32).reshape(SSD_GROUPS, SSD_HEADS_PER_GROUP)
    y_a = ssd_chunked_scan(xs, dt, a, bm, cm, d)
    y_a = rms_norm(y_a * jax.nn.silu(z_a), ssd_norm_w)
    q_b = q_b.reshape(bsz, L, GLA_HEADS, GLA_HEAD_K) * (GLA_HEAD_K ** -0.5)
    k_b = k_b.reshape(bsz, L, GLA_HEADS, GLA_HEAD_K)
    v_b = v_b.reshape(bsz, L, GLA_HEADS, GLA_HEAD_V)
    log_decay = jax.nn.log_sigmoid(gate_lr @ gate_w2.astype(jnp.float32) + gate_b.astype(jnp.float32)) / GLA_GATE_NORMALIZER
    log_decay = log_decay.reshape(bsz, L, GLA_HEADS, GLA_HEAD_K)
    o_b = gla_chunked(q_b, k_b, v_b, log_decay)
    o_b = rms_norm(o_b, gla_norm_w).reshape(bsz, L, GLA_VALUE_WIDTH) * jax.nn.silu(g_b)
    out = jnp.concatenate([y_a, o_b], axis=-1) @ w_out.astype(jnp.float32)
    return x + out.astype(x.dtype)


def moba_attention(q, k, v):
    b, H, L, d = q.shape
    nb = -(-L // MOBA_BLOCK)
    lp = nb * MOBA_BLOCK
    pad = ((0, 0), (0, 0), (0, lp - L), (0, 0))
    q = jnp.pad(q * (d ** -0.5), pad)
    k = jnp.pad(k, pad)
    v = jnp.pad(v, pad)
    kb = k.reshape(b, H, nb, MOBA_BLOCK, d)
    vb = v.reshape(b, H, nb, MOBA_BLOCK, d)
    k_mean = jnp.mean(kb, axis=3)
    gate = jnp.einsum('bhqd,bhnd->bhqn', q, k_mean).astype(jnp.float32)
    n_past_all = jnp.arange(lp) // MOBA_BLOCK
    fully_past = jnp.arange(nb)[None, :] < n_past_all[:, None]
    gate = jnp.where(fully_past, gate, -jnp.inf)
    k_sel = min(MOBA_TOPK, nb)
    _, top_idx = lax.top_k(gate, k_sel)
    bi = jnp.arange(b)[:, None, None]
    hi = jnp.arange(H)[None, :, None]

    def attend_chunk(start):
        qc = lax.dynamic_slice_in_dim(q, start, MOBA_Q_CHUNK, axis=2)
        idx_c = lax.dynamic_slice_in_dim(top_idx, start, MOBA_Q_CHUNK, axis=2)
        pos = start + jnp.arange(MOBA_Q_CHUNK)
        n_past = pos // MOBA_BLOCK
        logits = []
        for s in range(k_sel):
            ks = kb[bi, hi, idx_c[..., s]]
            ls = jnp.einsum('bhqd,bhqkd->bhqk', qc, ks).astype(jnp.float32)
            logits.append(jnp.where((s < n_past)[:, None], ls, -jnp.inf))
        own = start // MOBA_BLOCK
        ko = lax.dynamic_index_in_dim(kb, own, axis=2, keepdims=False)
        vo = lax.dynamic_index_in_dim(vb, own, axis=2, keepdims=False)
        lo = jnp.einsum('bhqd,bhkd->bhqk', qc, ko).astype(jnp.float32)
        key_pos = own * MOBA_BLOCK + jnp.arange(MOBA_BLOCK)
        logits.append(jnp.where(key_pos[None, :] <= pos[:, None], lo, -jnp.inf))
        p = jax.nn.softmax(jnp.concatenate(logits, axis=-1), axis=-1)
        p_parts = jnp.split(p, k_sel + 1, axis=-1)
        out = jnp.einsum('bhqk,bhkd->bhqd', p_parts[-1].astype(vo.dtype), vo)
        for s in range(k_sel):
            vs = vb[bi, hi, idx_c[..., s]]
            out = out + jnp.einsum('bhqk,bhqkd->bhqd', p_parts[s].astype(vs.dtype), vs)
        return out

    starts = jnp.arange(lp // MOBA_Q_CHUNK) * MOBA_Q_CHUNK
    outs = lax.map(attend_chunk, starts)
    out = jnp.moveaxis(outs, 0, 2).reshape(b, H, lp, d)
    return out[:, :, :L]


def moba_layer(x, norm_w, w_in, w_out):
    bsz, L, _ = x.shape
    h = rms_norm(x, norm_w)
    u = h @ w_in.astype(jnp.float32)
    q, k, v, z = split_cols(u, (MOBA_WIDTH, MOBA_WIDTH, MOBA_WIDTH, MOBA_WIDTH))
    to_heads = lambda t: t.reshape(bsz, L, MOBA_HEADS, MOBA_HEAD_DIM).transpose(0, 2, 1, 3)
    o = moba_attention(to_heads(q), to_heads(k), to_heads(v))
    o = o.transpose(0, 2, 1, 3).reshape(bsz, L, MOBA_WIDTH) * jax.nn.silu(z)
    return x + (o @ w_out.astype(jnp.float32)).astype(x.dtype)


def setup_inputs(seed: int = 0) -> dict:
    key = jax.random.key(seed)
    ks = jax.random.split(key, 20)
    nrm = jax.random.normal
    f32 = jnp.float32
    dt_init = jnp.exp(jax.random.uniform(ks[6], (N_EVEN, SSD_HEADS), f32, np.log(1e-3), np.log(1e-1)))
    return {
        'x': nrm(ks[0], (BATCH, SEQ, D_MODEL), f32),
        'even_norm': 1.0 + 0.02 * nrm(ks[1], (N_EVEN, D_MODEL), f32),
        'even_w_in': nrm(ks[2], (N_EVEN, D_MODEL, EVEN_IN_WIDTH), f32) * D_MODEL ** -0.5,
        'even_conv_w': nrm(ks[3], (N_EVEN, SSD_CONV, SSD_CONV_DIM), f32) * SSD_CONV ** -0.5,
        'even_conv_b': 0.02 * nrm(ks[4], (N_EVEN, SSD_CONV_DIM), f32),
        'even_a_log': jnp.log(jax.random.uniform(ks[5], (N_EVEN, SSD_HEADS), f32, 1.0, 16.0)),
        'even_dt_bias': dt_init + jnp.log(-jnp.expm1(-dt_init)),
        'even_d_skip': 1.0 + 0.1 * nrm(ks[7], (N_EVEN, SSD_HEADS), f32),
        'even_ssd_norm': 1.0 + 0.02 * nrm(ks[8], (N_EVEN, SSD_WIDTH), f32),
        'even_gate_w2': nrm(ks[9], (N_EVEN, GLA_GATE_RANK, GLA_KEY_WIDTH), f32) * GLA_GATE_RANK ** -0.5,
        'even_gate_b': 0.1 * nrm(ks[10], (N_EVEN, GLA_KEY_WIDTH), f32),
        'even_gla_norm': 1.0 + 0.02 * nrm(ks[11], (N_EVEN, GLA_HEAD_V), f32),
        'even_w_out': nrm(ks[12], (N_EVEN, EVEN_MIX_WIDTH, D_MODEL), f32) * EVEN_MIX_WIDTH ** -0.5,
        'odd_norm': 1.0 + 0.02 * nrm(ks[13], (N_ODD, D_MODEL), f32),
        'odd_w_in': nrm(ks[14], (N_ODD, D_MODEL, ODD_IN_WIDTH), f32) * D_MODEL ** -0.5,
        'odd_w_out': nrm(ks[15], (N_ODD, MOBA_WIDTH, D_MODEL), f32) * MOBA_WIDTH ** -0.5,
        'final_norm': 1.0 + 0.02 * nrm(ks[16], (D_MODEL,), f32),
    }


def reference(x, even_norm, even_w_in, even_conv_w, even_conv_b, even_a_log, even_dt_bias, even_d_skip, even_ssd_norm, even_gate_w2, even_gate_b, even_gla_norm, even_w_out, odd_norm, odd_w_in, odd_w_out, final_norm):
    for layer in range(DEPTH):
        i = layer // 2
        if layer % 2 == 0:
            x = ssd_gla_layer(x, even_norm[i], even_w_in[i], even_conv_w[i], even_conv_b[i], even_a_log[i], even_dt_bias[i], even_d_skip[i], even_ssd_norm[i], even_gate_w2[i], even_gate_b[i], even_gla_norm[i], even_w_out[i])
        else:
            x = moba_layer(x, odd_norm[i], odd_w_in[i], odd_w_out[i])
    return rms_norm(x, final_norm).astype(x.dtype)
```

```cpp
#include <hip/hip_runtime.h>
#include <cstdio>
#include <cstdint>

constexpr int BATCH = 8, SEQ = 2048, DM = 1024, MTOK = BATCH * SEQ;
constexpr int N0 = 5632, U0P = 5376;
constexpr int COL_Z = 0, COL_XBC = 1024, COL_Q = 2304, COL_K = 2816, COL_V = 3328, COL_G = 4352;
constexpr int N1 = 4096;
constexpr float RMS_EPS = 1e-6f;
constexpr float QK_C2 = 0.125f * 1.4426950408889634f;
constexpr size_t MiB = 1u << 20;
constexpr size_t WS_CTL = 0, CTL_BYTES = 2 * MiB;
constexpr size_t WS_BT0 = 2 * MiB;
constexpr size_t WS_BT2 = 2 * MiB, WS_BT3 = 10 * MiB;
constexpr size_t WS_BT1 = 13 * MiB;
constexpr size_t WS_SM = 17 * MiB;
constexpr size_t WS_U = 19 * MiB;
constexpr size_t WS_YG = 187 * MiB;
constexpr size_t WS_END = 251 * MiB;
constexpr size_t CTL_SSQ = 64 * 1024;
constexpr size_t CTL_KSUM = 256 * 1024;
constexpr size_t CTL_BAR = 1024 * 1024;

#define LAS __attribute__((address_space(3)))
typedef unsigned short bf16_t;
typedef unsigned v4u __attribute__((ext_vector_type(4)));
typedef unsigned v2u __attribute__((ext_vector_type(2)));
typedef float v4f __attribute__((ext_vector_type(4)));

__device__ __forceinline__ unsigned f2bf(float f) { unsigned u = __builtin_bit_cast(unsigned, f); return (u + 0x7fffu + ((u >> 16) & 1u)) >> 16; }
__device__ __forceinline__ unsigned pk2(float lo, float hi) { return f2bf(lo) | (f2bf(hi) << 16); }
__device__ __forceinline__ float bf2f(unsigned h) { return __builtin_bit_cast(float, h << 16); }
__device__ __forceinline__ float silu_f(float x) { return x / (1.f + __expf(-x)); }
__device__ __forceinline__ float softplus_f(float x) { return x > 20.f ? x : log1pf(__expf(x)); }
__device__ __forceinline__ float logsigmoid_f(float x) { return fminf(x, 0.f) - log1pf(__expf(-fabsf(x))); }
__device__ __forceinline__ float wave_sum(float v) {
#pragma unroll
    for (int o = 1; o < 64; o <<= 1) v += __shfl_xor(v, o);
    return v;
}
namespace pg8 {
#define PG8_LAS __attribute__((address_space(3)))
typedef unsigned short bf16_t;
typedef short bf16x8 __attribute__((ext_vector_type(8)));
typedef float f32x4 __attribute__((ext_vector_type(4)));
typedef unsigned u32x4 __attribute__((ext_vector_type(4)));
constexpr int BM = 256, BK = 64, HALF = 128, HTB = HALF * BK * 2  , STAGE_BYTES = 8 * HTB, NXCD = 8, WGM = 8;

__host__ __device__ __forceinline__ int lds_byte(int r, int c) { const int st = (r >> 4) * 2 + (c >> 5), rr = r & 15, cc = c & 31, ob = rr * 64 + cc * 2; return st * 1024 + (ob ^ (((ob >> 9) & 1) << 5)); }
__host__ __device__ __forceinline__ void stage_rc(int b, int& R, int& C) { const int st = b / 1024, sb = b % 1024, swz = sb ^ (((sb >> 9) & 1) << 5); R = (st >> 1) * 16 + swz / 64; C = (st & 1) * 32 + (swz % 64) / 2; }
__host__ __device__ __forceinline__ int perm32(int rho) { const int n = rho >> 4, i = rho & 15; return 8 * (i >> 2) + 4 * n + (i & 3); }

struct Unit { int pm, pn; };
struct Gemm { const bf16_t* A; const bf16_t* Bt; int M, N, K, pad; };

struct StaticOrder {
    int nM, nN, nwg, G, c;
    __host__ __device__ void init(int M, int N, int G_, int c_) { nM = M / BM; nN = N / BM; nwg = nM * nN; G = G_; c = c_; }
    __host__ __device__ bool next(int i, Unit& u) const {
        const long L = (long)i * G + c; if (L >= nwg) return false;
        int wgid = (int)L; { const int q = nwg / NXCD, r = nwg % NXCD, xcd = wgid % NXCD, off = wgid / NXCD; wgid = (xcd < r ? xcd * (q + 1) : r * (q + 1) + (xcd - r) * q) + off; }
        const int nig = WGM * nN, gid = wgid / nig, fm = gid * WGM, gsz = (nM - fm) < WGM ? (nM - fm) : WGM;
        u.pm = fm + ((wgid % nig) % gsz); u.pn = (wgid % nig) / gsz; return true;
    }
    __device__ __forceinline__ void a_ready(const Unit&) const {}
    __device__ __forceinline__ void done(const Unit&) const {}
};

__device__ __forceinline__ unsigned cvt_pk_bf16(float lo, float hi) { unsigned r; asm volatile("v_cvt_pk_bf16_f32 %0, %1, %2" : "=v"(r) : "v"(lo), "v"(hi)); return r; }

struct EpiU0 {
    static constexpr bool PERM = true, AFTER_DRAIN = false, MIDK = false;
    bf16_t* U; float* SM; int midk_t, pad;
    __device__ __forceinline__ void midk(f32x4 (&)[2][2][4][2], const Unit&, int, int) const {}
    __device__ __forceinline__ void operator()(const f32x4 (&acc)[2][2][4][2], const Unit& u, int wr, int wc, int fr, int fq) const {
        const int row0 = u.pm * BM + wr * 64 + fr;
        if (u.pn < 21) {
            const int col0 = u.pn * BM + wc * 32 + 8 * fq;
#pragma unroll
            for (int ai = 0; ai < 2; ++ai)
#pragma unroll
                for (int m = 0; m < 4; ++m) { bf16_t* rowp = U + (size_t)(row0 + ai * HALF + m * 16) * 5376 + col0;
#pragma unroll
                    for (int bj = 0; bj < 2; ++bj) { const f32x4 v0 = acc[ai][bj][m][0], v1 = acc[ai][bj][m][1];
                        u32x4 w; w.x = cvt_pk_bf16(v0[0], v0[1]); w.y = cvt_pk_bf16(v0[2], v0[3]); w.z = cvt_pk_bf16(v1[0], v1[1]); w.w = cvt_pk_bf16(v1[2], v1[3]);
                        *(u32x4*)(rowp + bj * HALF) = w; } }
        } else if (wc == 0) {
#pragma unroll
            for (int ai = 0; ai < 2; ++ai)
#pragma unroll
                for (int m = 0; m < 4; ++m) { float* rp = SM + (size_t)(row0 + ai * HALF + m * 16) * 32 + 8 * fq;
                    *(f32x4*)rp = acc[ai][0][m][0]; *(f32x4*)(rp + 4) = acc[ai][0][m][1]; }
        }
    }
};
template <bool SCALE> struct EpiRes {
    static constexpr bool PERM = false, AFTER_DRAIN = false, MIDK = SCALE;
    const float* base; float* out; const float* ssq; int midk_t, pad;
    __device__ __forceinline__ void midk(f32x4 (&acc)[2][2][4][2], const Unit& u, int wr, int fr) const {
#pragma unroll
        for (int ai = 0; ai < 2; ++ai)
#pragma unroll
            for (int m = 0; m < 4; ++m) { const float s = __builtin_amdgcn_rsqf(ssq[u.pm * BM + ai * HALF + wr * 64 + m * 16 + fr] * (1.0f / 1024.0f) + 1e-6f);
#pragma unroll
                for (int bj = 0; bj < 2; ++bj)
#pragma unroll
                    for (int n = 0; n < 2; ++n) acc[ai][bj][m][n] *= s; }
    }
    __device__ __forceinline__ void operator()(const f32x4 (&acc)[2][2][4][2], const Unit& u, int wr, int wc, int fr, int fq) const {
        const int col0 = u.pn * BM + wc * 32 + 4 * fq;
#pragma unroll
        for (int ai = 0; ai < 2; ++ai)
#pragma unroll
            for (int m = 0; m < 4; ++m) { const size_t off = (size_t)(u.pm * BM + ai * HALF + wr * 64 + m * 16 + fr) * 1024 + col0;
#pragma unroll
                for (int bj = 0; bj < 2; ++bj)
#pragma unroll
                    for (int n = 0; n < 2; ++n) { const f32x4 b = *(const f32x4*)(base + off + bj * HALF + n * 16); *(f32x4*)(out + off + bj * HALF + n * 16) = b + acc[ai][bj][m][n]; } }
    }
};
struct EpiU1 {
    static constexpr bool PERM = true, AFTER_DRAIN = false, MIDK = false;
    bf16_t* U; float* ksum; float qscale; int midk_t;
    __device__ __forceinline__ void midk(f32x4 (&)[2][2][4][2], const Unit&, int, int) const {}
    __device__ __forceinline__ void operator()(const f32x4 (&acc)[2][2][4][2], const Unit& u, int wr, int wc, int fr, int fq) const {
        const int row0 = u.pm * BM + wr * 64 + fr, col0 = u.pn * BM + wc * 32 + 8 * fq;
        const int kind = u.pn >> 2;
        const float sc = (kind == 0) ? qscale : 1.f;
#pragma unroll
        for (int ai = 0; ai < 2; ++ai)
#pragma unroll
            for (int m = 0; m < 4; ++m) { bf16_t* rowp = U + (size_t)(row0 + ai * HALF + m * 16) * 4096 + col0;
#pragma unroll
                for (int bj = 0; bj < 2; ++bj) { f32x4 v0 = acc[ai][bj][m][0] * sc, v1 = acc[ai][bj][m][1] * sc;
                    if (kind == 3) {
#pragma unroll
                        for (int i = 0; i < 4; ++i) { v0[i] = v0[i] * __builtin_amdgcn_rcpf(1.f + __builtin_amdgcn_exp2f(-1.4426950408889634f * v0[i])); v1[i] = v1[i] * __builtin_amdgcn_rcpf(1.f + __builtin_amdgcn_exp2f(-1.4426950408889634f * v1[i])); } }
                    u32x4 w; w.x = cvt_pk_bf16(v0[0], v0[1]); w.y = cvt_pk_bf16(v0[2], v0[3]); w.z = cvt_pk_bf16(v1[0], v1[1]); w.w = cvt_pk_bf16(v1[2], v1[3]);
                    *(u32x4*)(rowp + bj * HALF) = w; } }
        if (kind == 1) {
            float* kp = ksum + (size_t)u.pm * 1024 + (col0 - 1024);
#pragma unroll
            for (int bj = 0; bj < 2; ++bj)
#pragma unroll
                for (int n = 0; n < 2; ++n) { f32x4 s = (f32x4){0.f, 0.f, 0.f, 0.f};
#pragma unroll
                    for (int ai = 0; ai < 2; ++ai)
#pragma unroll
                        for (int m = 0; m < 4; ++m) s += acc[ai][bj][m][n];
#pragma unroll
                    for (int i = 0; i < 4; ++i) { float t = s[i]; t += __shfl_xor(t, 1); t += __shfl_xor(t, 2); t += __shfl_xor(t, 4); t += __shfl_xor(t, 8); s[i] = t; }
                    if (fr == 0) {
#pragma unroll
                        for (int i = 0; i < 4; ++i) atomicAdd(kp + bj * HALF + 4 * n + i, s[i]); } }
        }
    }
};
template <class Epi, class Sched, bool ALIGN_EPI = false, bool SP2 = false>
__device__ __forceinline__ void gemm_phase(PG8_LAS unsigned char* lds, const Gemm g, const Sched& S, const Epi& E) {
    const int tid = threadIdx.x, wid = __builtin_amdgcn_readfirstlane(tid >> 6), lane = tid & 63, wr = wid >> 2, wc = wid & 3, fr = lane & 15, fq = lane >> 4;
    const int K = g.K, nt = K / BK;
    unsigned voffA[2], voffB[2];
#pragma unroll
    for (int i = 0; i < 2; ++i) { int R, C; stage_rc(tid * 16 + i * 8192, R, C); const int Rb = Epi::PERM ? ((R & ~31) + perm32(R & 31)) : R;
        voffA[i] = (unsigned)(R * K + C) * 2u; voffB[i] = (unsigned)(Rb * K + C) * 2u; }
    const size_t kstep = (size_t)(BK * 2);
    const size_t hstep = (size_t)HALF * K * 2;
    const size_t tstep = 2 * hstep;
    const unsigned ldsw = (unsigned)wid * 1024u;
    const int aoff = lds_byte(wr * 64 + fr, fq * 8), boff = lds_byte(wc * 32 + fr, fq * 8);
#define PG8_SA(b, h) (((b) * 2 + (h)) * HTB)
#define PG8_SB(b, h) ((4 + (b) * 2 + (h)) * HTB)
#define PG8_STAGE(bufoff, gbase, voff) do { _Pragma("unroll") for (int _i = 0; _i < 2; ++_i) \
        __builtin_amdgcn_global_load_lds((const unsigned*)((const char*)(gbase) + (voff)[_i]), (PG8_LAS unsigned*)(lds + (bufoff) + ldsw + _i * 8192), 16, 0, 0); } while (0)
#define PG8_LDA(dst, b, h) do { _Pragma("unroll") for (int m = 0; m < 4; ++m) _Pragma("unroll") for (int k = 0; k < 2; ++k) dst[m][k] = *(const PG8_LAS bf16x8*)(lds + PG8_SA(b, h) + aoff + m * 2048 + k * 1024); } while (0)
#define PG8_LDB(dst, b, h) do { _Pragma("unroll") for (int n = 0; n < 2; ++n) _Pragma("unroll") for (int k = 0; k < 2; ++k) dst[n][k] = *(const PG8_LAS bf16x8*)(lds + PG8_SB(b, h) + boff + n * 2048 + k * 1024); } while (0)
#define PG8_MMA(ai, bj, At, Bt) do { __builtin_amdgcn_s_setprio(1); _Pragma("unroll") for (int m = 0; m < 4; ++m) _Pragma("unroll") for (int n = 0; n < 2; ++n) _Pragma("unroll") for (int k = 0; k < 2; ++k) \
        acc[ai][bj][m][n] = __builtin_amdgcn_mfma_f32_16x16x32_bf16(Bt[n][k], At[m][k], acc[ai][bj][m][n], 0, 0, 0); __builtin_amdgcn_s_setprio(0); } while (0)
#define PG8_WAIT_V(n) asm volatile("s_waitcnt vmcnt(" #n ")" ::: "memory")
#define PG8_WAIT_L(n) asm volatile("s_waitcnt lgkmcnt(" #n ")" ::: "memory")
#define PG8_BAR __builtin_amdgcn_s_barrier()
#define PG8_SCHED __builtin_amdgcn_sched_barrier(0)
    Unit cur, nxt; int ui = 0;
    if (!S.next(0, cur)) return;
    f32x4 acc[2][2][4][2];
#pragma unroll
    for (int a = 0; a < 2; ++a)
#pragma unroll
        for (int b = 0; b < 2; ++b)
#pragma unroll
            for (int m = 0; m < 4; ++m)
#pragma unroll
                for (int n = 0; n < 2; ++n) acc[a][b][m][n] = (f32x4){0.f, 0.f, 0.f, 0.f};
    bf16x8 At[4][2], B0[2][2], B1[2][2];
    const char* cA = (const char*)g.A + (size_t)cur.pm * tstep; const char* cB = (const char*)g.Bt + (size_t)cur.pn * tstep;
    S.a_ready(cur);
    if constexpr (SP2) {
        PG8_STAGE(PG8_SB(0, 0), cB, voffB); PG8_STAGE(PG8_SB(0, 1), cB + hstep, voffB); PG8_STAGE(PG8_SA(0, 0), cA, voffA); PG8_STAGE(PG8_SA(0, 1), cA + hstep, voffA);
        if (wr == 1) PG8_BAR;
        PG8_WAIT_V(2); PG8_BAR;
        PG8_STAGE(PG8_SB(1, 0), cB + kstep, voffB); PG8_STAGE(PG8_SA(1, 0), cA + kstep, voffA); PG8_STAGE(PG8_SB(1, 1), cB + hstep + kstep, voffB);
        PG8_WAIT_V(6); PG8_BAR;
    } else {
        PG8_STAGE(PG8_SB(0, 0), cB, voffB); PG8_STAGE(PG8_SA(0, 0), cA, voffA); PG8_STAGE(PG8_SB(0, 1), cB + hstep, voffB); PG8_STAGE(PG8_SA(0, 1), cA + hstep, voffA);
        if (wr == 1) PG8_BAR;
        PG8_WAIT_V(4); PG8_BAR;
        PG8_STAGE(PG8_SB(1, 0), cB + kstep, voffB); PG8_STAGE(PG8_SA(1, 0), cA + kstep, voffA); PG8_STAGE(PG8_SB(1, 1), cB + hstep + kstep, voffB);
        PG8_WAIT_V(6); PG8_BAR;
    }
    for (;;) {
        const bool has_next = S.next(ui + 1, nxt);
        const char* nA = has_next ? (const char*)g.A + (size_t)nxt.pm * tstep : cA; const char* nB = has_next ? (const char*)g.Bt + (size_t)nxt.pn * tstep : cB;
        for (int t = 0; t < nt; t += 2) {
            if constexpr (Epi::MIDK) { if (t == E.midk_t) E.midk(acc, cur, wr, fr); }
            const bool last = (t == nt - 2);
            const char* a1 = cA + (size_t)(t + 1) * kstep;
            const char* a2 = last ? nA : cA + (size_t)(t + 2) * kstep; const char* b2 = last ? nB : cB + (size_t)(t + 2) * kstep;
            const char* a3 = a2 + kstep; const char* b3 = b2 + kstep;
            if (last && has_next) S.a_ready(nxt);
            if constexpr (SP2) {
            PG8_LDB(B0, 0, 0); PG8_LDB(B1, 0, 1); PG8_SCHED; PG8_LDA(At, 0, 0); PG8_STAGE(PG8_SA(1, 1), a1 + hstep, voffA);
            PG8_WAIT_V(8); PG8_WAIT_L(0); PG8_BAR; PG8_MMA(0, 0, At, B0); PG8_MMA(0, 1, At, B1); PG8_BAR; PG8_SCHED;
            PG8_LDA(At, 0, 1); PG8_STAGE(PG8_SB(0, 0), b2, voffB); PG8_STAGE(PG8_SB(0, 1), b2 + hstep, voffB); PG8_STAGE(PG8_SA(0, 0), a2, voffA);
            PG8_WAIT_V(8); PG8_WAIT_L(0); PG8_BAR; PG8_MMA(1, 0, At, B0); PG8_MMA(1, 1, At, B1); PG8_BAR; PG8_SCHED;
            PG8_LDB(B0, 1, 0); PG8_LDB(B1, 1, 1); PG8_SCHED; PG8_LDA(At, 1, 0); PG8_STAGE(PG8_SA(0, 1), a2 + hstep, voffA);
            PG8_WAIT_V(8); PG8_WAIT_L(0); PG8_BAR; PG8_MMA(0, 0, At, B0); PG8_MMA(0, 1, At, B1); PG8_BAR; PG8_SCHED;
            PG8_LDA(At, 1, 1); PG8_STAGE(PG8_SB(1, 0), b3, voffB); PG8_STAGE(PG8_SB(1, 1), b3 + hstep, voffB); PG8_STAGE(PG8_SA(1, 0), a3, voffA);
            PG8_WAIT_V(8); PG8_WAIT_L(0); PG8_BAR; PG8_MMA(1, 0, At, B0); PG8_MMA(1, 1, At, B1); PG8_BAR; PG8_SCHED;
            } else {
            PG8_LDB(B0, 0, 0); PG8_SCHED; PG8_LDA(At, 0, 0); PG8_STAGE(PG8_SA(1, 1), a1 + hstep, voffA);
            PG8_WAIT_L(8); PG8_BAR; PG8_WAIT_L(0); PG8_MMA(0, 0, At, B0); PG8_BAR; PG8_SCHED;
            PG8_LDB(B1, 0, 1); PG8_STAGE(PG8_SB(0, 0), b2, voffB);
            PG8_BAR; PG8_WAIT_L(0); PG8_MMA(0, 1, At, B1); PG8_BAR;
            PG8_LDA(At, 0, 1); PG8_STAGE(PG8_SA(0, 0), a2, voffA);
            PG8_BAR; PG8_WAIT_L(0); PG8_MMA(1, 0, At, B0); PG8_BAR; PG8_SCHED;
            PG8_STAGE(PG8_SB(0, 1), b2 + hstep, voffB);
            PG8_WAIT_V(6); PG8_BAR; PG8_MMA(1, 1, At, B1); PG8_BAR;
            PG8_LDB(B0, 1, 0); PG8_SCHED; PG8_LDA(At, 1, 0); PG8_STAGE(PG8_SA(0, 1), a2 + hstep, voffA);
            PG8_WAIT_L(8); PG8_BAR; PG8_WAIT_L(0); PG8_MMA(0, 0, At, B0); PG8_BAR; PG8_SCHED;
            PG8_LDB(B1, 1, 1); PG8_STAGE(PG8_SB(1, 0), b3, voffB);
            PG8_BAR; PG8_WAIT_L(0); PG8_MMA(0, 1, At, B1); PG8_BAR;
            PG8_LDA(At, 1, 1); PG8_STAGE(PG8_SA(1, 0), a3, voffA);
            PG8_BAR; PG8_WAIT_L(0); PG8_MMA(1, 0, At, B0); PG8_BAR; PG8_SCHED;
            PG8_STAGE(PG8_SB(1, 1), b3 + hstep, voffB);
            PG8_WAIT_V(6); PG8_BAR; PG8_MMA(1, 1, At, B1); PG8_BAR;
            }
        }
        if constexpr (ALIGN_EPI) { if (wr == 0) PG8_BAR; }
        if constexpr (!Epi::AFTER_DRAIN) { E(acc, cur, wr, wc, fr, fq); S.done(cur); }
        if (!has_next) break;
#pragma unroll
        for (int a = 0; a < 2; ++a)
#pragma unroll
            for (int b = 0; b < 2; ++b)
#pragma unroll
                for (int m = 0; m < 4; ++m)
#pragma unroll
                    for (int n = 0; n < 2; ++n) acc[a][b][m][n] = (f32x4){0.f, 0.f, 0.f, 0.f};
        cur = nxt; cA = nA; cB = nB; ++ui;
        if constexpr (ALIGN_EPI) { if (wr == 1) PG8_BAR; }
    }
    PG8_WAIT_V(0);
    if constexpr (!ALIGN_EPI) { if (wr == 0) PG8_BAR; }
    PG8_BAR;
    if constexpr (Epi::AFTER_DRAIN) { E.fused(acc, cur, wr, wc, fr, fq, lds, wid, lane); S.done(cur); }
#undef PG8_SA
#undef PG8_SB
#undef PG8_STAGE
#undef PG8_LDA
#undef PG8_LDB
#undef PG8_MMA
#undef PG8_WAIT_V
#undef PG8_WAIT_L
#undef PG8_BAR
#undef PG8_SCHED
}
}

template <class Epi> __global__ void __launch_bounds__(512, 2) gemm_kernel(pg8::Gemm g, Epi E) {
    extern __shared__ __attribute__((aligned(16))) unsigned char lds[];
    pg8::StaticOrder S; S.init(g.M, g.N, (int)gridDim.x, (int)blockIdx.x);
    pg8::gemm_phase<Epi, pg8::StaticOrder, true, true>((LAS unsigned char*)lds, g, S, E);
}

template <int MAP> __device__ __forceinline__ int map_col(int n) {
    if (MAP == 0) return n;
    if (n < 2304) return n; if (n < 4352) return n + 16; if (n < 5376) return n + 32; if (n < 5392) return n - 5376 + 2304; if (n < 5408) return n - 5392 + 4368; return -1;
}
template <int MAP> __device__ __forceinline__ void transpose_item(const float* W, int K, int Nsrc, int Ndst, const float* kscale, int kscale_n, bf16_t* WT, LAS float* scr, int item, int lane) {
    const int nblk = Ndst / 32, kb = item / nblk, nb = item % nblk, k0 = 64 * kb, n0 = 32 * nb;
    const int sc = map_col<MAP>(n0 + (lane & 31));
#pragma unroll 8
    for (int i = 0; i < 32; ++i) { const int kk = 2 * i + (lane >> 5); float v = sc >= 0 ? W[(size_t)(k0 + kk) * Nsrc + sc] : 0.f; if (kscale && (k0 + kk) < kscale_n) v *= kscale[k0 + kk]; scr[kk * 33 + (lane & 31)] = v; }
    asm volatile("s_waitcnt lgkmcnt(0)" ::: "memory");
    const int c = lane & 7;
#pragma unroll
    for (int j = 0; j < 4; ++j) { const int n = (lane >> 3) + 8 * j; const LAS float* s = scr + (8 * c) * 33 + n;
        v4u o; o.x = pk2(s[0 * 33], s[1 * 33]); o.y = pk2(s[2 * 33], s[3 * 33]); o.z = pk2(s[4 * 33], s[5 * 33]); o.w = pk2(s[6 * 33], s[7 * 33]);
        *(v4u*)(WT + (size_t)(n0 + n) * K + k0 + 8 * c) = o; }
    asm volatile("s_waitcnt lgkmcnt(0)" ::: "memory");
}
__device__ __forceinline__ void rms_row_to_bf16(const float* xrow, const float* w, bf16_t* orow, int lane) {
    const v4f* xr = (const v4f*)xrow + lane; const v4f* wr = (const v4f*)w + lane;
    v4f v[4]; float s = 0.f;
#pragma unroll
    for (int j = 0; j < 4; ++j) { v[j] = xr[64 * j]; s += (v[j].x * v[j].x + v[j].y * v[j].y) + (v[j].z * v[j].z + v[j].w * v[j].w); }
    const float rstd = 1.0f / sqrtf(wave_sum(s) * (1.f / 1024.f) + RMS_EPS);
    unsigned long long* o8 = (unsigned long long*)orow + lane;
#pragma unroll
    for (int j = 0; j < 4; ++j) { const v4f ww = wr[64 * j]; o8[64 * j] = (unsigned long long)pk2(v[j].x * rstd * ww.x, v[j].y * rstd * ww.y) | ((unsigned long long)pk2(v[j].z * rstd * ww.z, v[j].w * rstd * ww.w) << 32); }
}
__device__ __forceinline__ void rms_row_f32(const float* xrow, const float* w, float* orow, int lane) {
    const v4f* xr = (const v4f*)xrow + lane; const v4f* wr = (const v4f*)w + lane;
    v4f v[4]; float s = 0.f;
#pragma unroll
    for (int j = 0; j < 4; ++j) { v[j] = xr[64 * j]; s += (v[j].x * v[j].x + v[j].y * v[j].y) + (v[j].z * v[j].z + v[j].w * v[j].w); }
    const float rstd = 1.0f / sqrtf(wave_sum(s) * (1.f / 1024.f) + RMS_EPS);
    v4f* o = (v4f*)orow + lane;
#pragma unroll
    for (int j = 0; j < 4; ++j) o[64 * j] = v[j] * rstd * wr[64 * j];
}

struct Params {
    const float *x, *even_norm, *even_w_in, *conv_w, *conv_b, *a_log, *dt_bias, *d_skip, *ssd_norm, *gate_w2, *gate_b, *gla_norm, *even_w_out, *odd_norm, *odd_w_in, *odd_w_out, *final_norm;
    float* out; unsigned char* ws;
};

__global__ void __launch_bounds__(512) p0_kernel(Params P) {
    __shared__ float scr_all[8 * 64 * 33];
    const int lane = threadIdx.x & 63, wave = threadIdx.x >> 6, gw = blockIdx.x * 8 + wave, NGW = gridDim.x * 8;
    LAS float* scr = (LAS float*)scr_all + wave * 64 * 33;
    constexpr int I_A = (1024 / 64) * (N0 / 32), I_B = (2048 / 64) * (1024 / 32);
    for (int it = gw; it < I_A + I_B; it += NGW) {
        if (it < I_A) transpose_item<1>(P.even_w_in, 1024, 5408, N0, nullptr, 0, (bf16_t*)(P.ws + WS_BT0), scr, it, lane);
        else transpose_item<0>(P.even_w_out, 2048, 1024, 1024, P.ssd_norm, 1024, (bf16_t*)(P.ws + WS_BT1), scr, it - I_A, lane);
    }
    for (int m = gw; m < MTOK; m += NGW) rms_row_to_bf16(P.x + (size_t)m * 1024, P.even_norm, (bf16_t*)P.out + (size_t)m * 1024, lane);
}
__global__ void __launch_bounds__(512) p3b_kernel(Params P) {
    __shared__ float scr_all[8 * 64 * 33];
    const int lane = threadIdx.x & 63, wave = threadIdx.x >> 6, gw = blockIdx.x * 8 + wave, NGW = gridDim.x * 8;
    LAS float* scr = (LAS float*)scr_all + wave * 64 * 33;
    constexpr int I_A = (1024 / 64) * (4096 / 32), I_B = (1024 / 64) * (1024 / 32);
    for (int it = gw; it < I_A + I_B; it += NGW) {
        if (it < I_A) transpose_item<0>(P.odd_w_in, 1024, 4096, 4096, nullptr, 0, (bf16_t*)(P.ws + WS_BT2), scr, it, lane);
        else transpose_item<0>(P.odd_w_out, 1024, 1024, 1024, nullptr, 0, (bf16_t*)(P.ws + WS_BT3), scr, it - I_A, lane);
    }
    for (int m = gw; m < MTOK; m += NGW) rms_row_to_bf16(P.out + (size_t)m * 1024, P.odd_norm, (bf16_t*)(P.ws + WS_YG) + (size_t)m * 1024, lane);
}
__global__ void __launch_bounds__(512) p7_kernel(Params P) {
    const int lane = threadIdx.x & 63, wave = threadIdx.x >> 6, gw = blockIdx.x * 8 + wave, NGW = gridDim.x * 8;
    for (int m = gw; m < MTOK; m += NGW) rms_row_f32(P.out + (size_t)m * 1024, P.final_norm, P.out + (size_t)m * 1024, lane);
}

__global__ void __launch_bounds__(64) ssd_naive(Params P) {
    const bf16_t* U0 = (const bf16_t*)(P.ws + WS_U); const float* SM = (const float*)(P.ws + WS_SM);
    bf16_t* YG = (bf16_t*)(P.ws + WS_YG); float* ssq = (float*)(P.ws + WS_CTL + CTL_SSQ);
    const int b = blockIdx.x / 16, hd = blockIdx.x % 16, g = hd / 8, p = threadIdx.x;
    __shared__ float sB[64], sC[64];
    const int cx = hd * 64 + p, cB = 1024 + g * 64 + p, cC = 1152 + g * 64 + p;
    float wx[4], wB[4], wC[4];
#pragma unroll
    for (int k = 0; k < 4; ++k) { wx[k] = P.conv_w[k * 1280 + cx]; wB[k] = P.conv_w[k * 1280 + cB]; wC[k] = P.conv_w[k * 1280 + cC]; }
    const float bx = P.conv_b[cx], bB = P.conv_b[cB], bC = P.conv_b[cC];
    const float a = -__expf(P.a_log[hd]), dtb = P.dt_bias[hd], Dk = P.d_skip[hd];
    float h[64];
#pragma unroll
    for (int n = 0; n < 64; ++n) h[n] = 0.f;
    float ux0 = 0.f, ux1 = 0.f, ux2 = 0.f, uB0 = 0.f, uB1 = 0.f, uB2 = 0.f, uC0 = 0.f, uC1 = 0.f, uC2 = 0.f;
    for (int t = 0; t < SEQ; ++t) {
        const size_t row = (size_t)b * SEQ + t;
        const bf16_t* ur = U0 + row * U0P + COL_XBC;
        const float x3 = bf2f(ur[cx]), b3 = bf2f(ur[cB]), c3 = bf2f(ur[cC]);
        const float xc = silu_f(bx + wx[0] * ux0 + wx[1] * ux1 + wx[2] * ux2 + wx[3] * x3);
        const float Bc = silu_f(bB + wB[0] * uB0 + wB[1] * uB1 + wB[2] * uB2 + wB[3] * b3);
        const float Cc = silu_f(bC + wC[0] * uC0 + wC[1] * uC1 + wC[2] * uC2 + wC[3] * c3);
        ux0 = ux1; ux1 = ux2; ux2 = x3; uB0 = uB1; uB1 = uB2; uB2 = b3; uC0 = uC1; uC1 = uC2; uC2 = c3;
        __syncthreads();
        sB[p] = Bc; sC[p] = Cc;
        __syncthreads();
        const float dt = softplus_f(SM[row * 32 + hd] + dtb), dA = __expf(dt * a), xdt = xc * dt;
        float y = 0.f;
#pragma unroll
        for (int n = 0; n < 64; ++n) { h[n] = dA * h[n] + xdt * sB[n]; y += sC[n] * h[n]; }
        y += Dk * xc;
        const float z = bf2f(U0[row * U0P + COL_Z + cx]);
        const float yg = y * silu_f(z);
        YG[row * 2048 + cx] = (bf16_t)f2bf(yg);
        const float s = wave_sum(yg * yg);
        if (p == 0) atomicAdd(&ssq[row], s);
    }
}
__global__ void __launch_bounds__(64) gla_naive(Params P) {
    const bf16_t* U0 = (const bf16_t*)(P.ws + WS_U); const float* SM = (const float*)(P.ws + WS_SM);
    bf16_t* YG = (bf16_t*)(P.ws + WS_YG);
    const int b = blockIdx.x / 8, h = blockIdx.x % 8, l = threadIdx.x;
    __shared__ float sq[64], sk[64], sd[64];
    float w2[16];
#pragma unroll
    for (int r = 0; r < 16; ++r) w2[r] = P.gate_w2[r * 512 + h * 64 + l];
    const float gb = P.gate_b[h * 64 + l], nw0 = P.gla_norm[l], nw1 = P.gla_norm[l + 64];
    float S0[64], S1[64];
#pragma unroll
    for (int d = 0; d < 64; ++d) { S0[d] = 0.f; S1[d] = 0.f; }
    for (int t = 0; t < SEQ; ++t) {
        const size_t row = (size_t)b * SEQ + t;
        const bf16_t* ur = U0 + row * U0P;
        float pre = gb;
#pragma unroll
        for (int r = 0; r < 16; ++r) pre += SM[row * 32 + 16 + r] * w2[r];
        const float dec = __expf(logsigmoid_f(pre) * (1.0f / 16.0f));
        __syncthreads();
        sq[l] = bf2f(ur[COL_Q + h * 64 + l]) * 0.125f; sk[l] = bf2f(ur[COL_K + h * 64 + l]); sd[l] = dec;
        __syncthreads();
        const float v0 = bf2f(ur[COL_V + h * 128 + l]), v1 = bf2f(ur[COL_V + h * 128 + 64 + l]);
        float o0 = 0.f, o1 = 0.f;
#pragma unroll
        for (int d = 0; d < 64; ++d) { const float dd = sd[d], kk = sk[d], qq = sq[d]; S0[d] = dd * S0[d] + kk * v0; S1[d] = dd * S1[d] + kk * v1; o0 += qq * S0[d]; o1 += qq * S1[d]; }
        const float rstd = 1.0f / sqrtf(wave_sum(o0 * o0 + o1 * o1) * (1.0f / 128.0f) + RMS_EPS);
        const float g0 = bf2f(ur[COL_G + h * 128 + l]), g1 = bf2f(ur[COL_G + h * 128 + 64 + l]);
        YG[row * 2048 + 1024 + h * 128 + l] = (bf16_t)f2bf(o0 * rstd * nw0 * silu_f(g0));
        YG[row * 2048 + 1024 + h * 128 + 64 + l] = (bf16_t)f2bf(o1 * rstd * nw1 * silu_f(g1));
    }
}
__global__ void __launch_bounds__(256) moba_naive(Params P) {
    const bf16_t* U1 = (const bf16_t*)(P.ws + WS_U); const float* ksum = (const float*)(P.ws + WS_CTL + CTL_KSUM);
    bf16_t* O = (bf16_t*)(P.ws + WS_YG + 32 * MiB);
    const int unit = blockIdx.x, b = unit / 128, h = (unit / 8) % 16, nb = unit % 8;
    const int t = nb * 256 + threadIdx.x; const size_t row = (size_t)b * SEQ + t;
    __shared__ float skm[8 * 64];
    for (int i = threadIdx.x; i < 8 * 64; i += 256) skm[i] = ksum[(size_t)(b * 8 + (i >> 6)) * 1024 + h * 64 + (i & 63)];
    __syncthreads();
    float q[64];
    { const bf16_t* qp = U1 + row * 4096 + h * 64;
#pragma unroll
      for (int d = 0; d < 64; ++d) q[d] = bf2f(qp[d]); }
    float gate[8];
#pragma unroll
    for (int j = 0; j < 8; ++j) { float s = 0.f;
#pragma unroll
        for (int d = 0; d < 64; ++d) s += q[d] * skm[j * 64 + d];
        gate[j] = s; }
    unsigned sel = 0;
#pragma unroll
    for (int j = 0; j < 8; ++j) { if (j < nb) { int rank = 0;
#pragma unroll
            for (int i = 0; i < 8; ++i) if (i < nb && (gate[i] > gate[j] || (gate[i] == gate[j] && i < j))) ++rank;
            if (rank < 3) sel |= 1u << j; } }
    float m = -1e30f, lsum = 0.f, o[64];
#pragma unroll
    for (int d = 0; d < 64; ++d) o[d] = 0.f;
    for (int jj = 0; jj <= nb; ++jj) {
        const int j = (jj == 0) ? nb : jj - 1;
        const bool own = (j == nb);
        if (!own && !__any((sel >> j) & 1u)) continue;
        const bool lane_on = own || ((sel >> j) & 1u);
        for (int kk = 0; kk < 256; ++kk) {
            const int key = j * 256 + kk;
            if (own && key > nb * 256 + 255) break;
            const bool ok = lane_on && (!own || key <= t);
            if (!__any(ok)) { if (own) break; else continue; }
            const bf16_t* kp = U1 + ((size_t)b * SEQ + key) * 4096 + 1024 + h * 64;
            const bf16_t* vp = kp + 1024;
            float s = 0.f;
#pragma unroll
            for (int d = 0; d < 64; ++d) s += q[d] * bf2f(kp[d]);
            if (ok) {
                const float mn = fmaxf(m, s), f = __builtin_amdgcn_exp2f(m - mn), pr = __builtin_amdgcn_exp2f(s - mn);
                lsum = lsum * f + pr; m = mn;
#pragma unroll
                for (int d = 0; d < 64; ++d) o[d] = o[d] * f + pr * bf2f(vp[d]);
            }
        }
    }
    const float inv = 1.0f / lsum;
    const bf16_t* zp = U1 + row * 4096 + 3072 + h * 64; bf16_t* op = O + row * 1024 + h * 64;
#pragma unroll
    for (int d = 0; d < 64; ++d) op[d] = (bf16_t)f2bf(o[d] * inv * bf2f(zp[d]));
}

extern "C" void kernel_launch(void* const* d_in, const int* in_sizes, int n_in, void* d_out, int out_size, void* d_ws, size_t ws_size, hipStream_t stream) {
    static int init = 0;
    if (init == 0) {
        init = 1;
        if (n_in != 17 || in_sizes[0] != MTOK * DM || out_size != MTOK * DM || ws_size < WS_END) { fprintf(stderr, "kernel_launch: unexpected shapes (n_in %d, in0 %d, out %d, ws %zu)\n", n_in, n_in > 0 ? in_sizes[0] : -1, out_size, ws_size); init = -1; return; }
        hipFuncSetAttribute((const void*)gemm_kernel<pg8::EpiU0>, hipFuncAttributeMaxDynamicSharedMemorySize, pg8::STAGE_BYTES);
        hipFuncSetAttribute((const void*)gemm_kernel<pg8::EpiRes<true>>, hipFuncAttributeMaxDynamicSharedMemorySize, pg8::STAGE_BYTES);
        hipFuncSetAttribute((const void*)gemm_kernel<pg8::EpiRes<false>>, hipFuncAttributeMaxDynamicSharedMemorySize, pg8::STAGE_BYTES);
        hipFuncSetAttribute((const void*)gemm_kernel<pg8::EpiU1>, hipFuncAttributeMaxDynamicSharedMemorySize, pg8::STAGE_BYTES);
    }
    if (init < 0) return;
    Params P{};
    const float** pp = (const float**)&P;
    for (int i = 0; i < 17; ++i) pp[i] = (const float*)d_in[i];
    P.out = (float*)d_out; P.ws = (unsigned char*)d_ws;
    unsigned char* ws = (unsigned char*)d_ws;
    hipMemsetAsync(ws + WS_CTL, 0, CTL_BYTES, stream);
    const int G = 256;
    p0_kernel<<<G, 512, 0, stream>>>(P);
    { pg8::Gemm g{(const bf16_t*)d_out, (const bf16_t*)(ws + WS_BT0), MTOK, N0, 1024}; pg8::EpiU0 E{(bf16_t*)(ws + WS_U), (float*)(ws + WS_SM), -1};
      gemm_kernel<pg8::EpiU0><<<G, 512, pg8::STAGE_BYTES, stream>>>(g, E); }
    ssd_naive<<<BATCH * 16, 64, 0, stream>>>(P);
    gla_naive<<<BATCH * 8, 64, 0, stream>>>(P);
    { pg8::Gemm g{(const bf16_t*)(ws + WS_YG), (const bf16_t*)(ws + WS_BT1), MTOK, 1024, 2048}; pg8::EpiRes<true> E{P.x, P.out, (const float*)(ws + WS_CTL + CTL_SSQ), 16};
      gemm_kernel<pg8::EpiRes<true>><<<G, 512, pg8::STAGE_BYTES, stream>>>(g, E); }
    p3b_kernel<<<G, 512, 0, stream>>>(P);
    { pg8::Gemm g{(const bf16_t*)(ws + WS_YG), (const bf16_t*)(ws + WS_BT2), MTOK, N1, 1024}; pg8::EpiU1 E{(bf16_t*)(ws + WS_U), (float*)(ws + WS_CTL + CTL_KSUM), QK_C2, -1};
      gemm_kernel<pg8::EpiU1><<<G, 512, pg8::STAGE_BYTES, stream>>>(g, E); }
    moba_naive<<<BATCH * 16 * 8, 256, 0, stream>>>(P);
    { pg8::Gemm g{(const bf16_t*)(ws + WS_YG + 32 * MiB), (const bf16_t*)(ws + WS_BT3), MTOK, 1024, 1024}; pg8::EpiRes<false> E{P.out, P.out, nullptr, -1};
      gemm_kernel<pg8::EpiRes<false>><<<G, 512, pg8::STAGE_BYTES, stream>>>(g, E); }
    p7_kernel<<<G, 512, 0, stream>>>(P);
}
```

```cpp
#include <hip/hip_runtime.h>
#include <cstdio>
#include <cstdint>

constexpr int BATCH = 8, SEQ = 2048, DM = 1024, MTOK = BATCH * SEQ;
constexpr int N0 = 5632, U0P = 5376;
constexpr int COL_Z = 0, COL_XBC = 1024, COL_Q = 2304, COL_K = 2816, COL_V = 3328, COL_G = 4352;
constexpr int N1 = 4096;
constexpr float RMS_EPS = 1e-6f;
constexpr float QK_C2 = 0.125f * 1.4426950408889634f;
constexpr size_t MiB = 1u << 20;
constexpr size_t WS_CTL = 0, CTL_BYTES = 2 * MiB;
constexpr size_t WS_BT0 = 2 * MiB;
constexpr size_t WS_BT2 = 2 * MiB, WS_BT3 = 10 * MiB;
constexpr size_t WS_BT1 = 13 * MiB;
constexpr size_t WS_SM = 17 * MiB;
constexpr size_t WS_U = 19 * MiB;
constexpr size_t WS_YG = 187 * MiB;
constexpr size_t WS_END = 251 * MiB;
constexpr size_t CTL_SSQ = 64 * 1024;
constexpr size_t CTL_KSUM = 256 * 1024;
constexpr size_t CTL_BAR = 1024 * 1024;

#define LAS __attribute__((address_space(3)))
typedef unsigned short bf16_t;
typedef unsigned v4u __attribute__((ext_vector_type(4)));
typedef unsigned v2u __attribute__((ext_vector_type(2)));
typedef float v4f __attribute__((ext_vector_type(4)));

__device__ __forceinline__ unsigned f2bf(float f) { unsigned u = __builtin_bit_cast(unsigned, f); return (u + 0x7fffu + ((u >> 16) & 1u)) >> 16; }
__device__ __forceinline__ unsigned pk2(float lo, float hi) { return f2bf(lo) | (f2bf(hi) << 16); }
__device__ __forceinline__ float bf2f(unsigned h) { return __builtin_bit_cast(float, h << 16); }
__device__ __forceinline__ float silu_f(float x) { return x / (1.f + __expf(-x)); }
__device__ __forceinline__ float softplus_f(float x) { return x > 20.f ? x : log1pf(__expf(x)); }
__device__ __forceinline__ float logsigmoid_f(float x) { return fminf(x, 0.f) - log1pf(__expf(-fabsf(x))); }
__device__ __forceinline__ float wave_sum(float v) {
#pragma unroll
    for (int o = 1; o < 64; o <<= 1) v += __shfl_xor(v, o);
    return v;
}
namespace pg8 {
#define PG8_LAS __attribute__((address_space(3)))
typedef unsigned short bf16_t;
typedef short bf16x8 __attribute__((ext_vector_type(8)));
typedef float f32x4 __attribute__((ext_vector_type(4)));
typedef unsigned u32x4 __attribute__((ext_vector_type(4)));
constexpr int BM = 256, BK = 64, HALF = 128, HTB = HALF * BK * 2  , STAGE_BYTES = 8 * HTB, NXCD = 8, WGM = 8;

__host__ __device__ __forceinline__ int lds_byte(int r, int c) { const int st = (r >> 4) * 2 + (c >> 5), rr = r & 15, cc = c & 31, ob = rr * 64 + cc * 2; return st * 1024 + (ob ^ (((ob >> 9) & 1) << 5)); }
__host__ __device__ __forceinline__ void stage_rc(int b, int& R, int& C) { const int st = b / 1024, sb = b % 1024, swz = sb ^ (((sb >> 9) & 1) << 5); R = (st >> 1) * 16 + swz / 64; C = (st & 1) * 32 + (swz % 64) / 2; }
__host__ __device__ __forceinline__ int perm32(int rho) { const int n = rho >> 4, i = rho & 15; return 8 * (i >> 2) + 4 * n + (i & 3); }

struct Unit { int pm, pn; };
struct Gemm { const bf16_t* A; const bf16_t* Bt; int M, N, K, pad; };

struct StaticOrder {
    int nM, nN, nwg, G, c;
    __host__ __device__ void init(int M, int N, int G_, int c_) { nM = M / BM; nN = N / BM; nwg = nM * nN; G = G_; c = c_; }
    __host__ __device__ bool next(int i, Unit& u) const {
        const long L = (long)i * G + c; if (L >= nwg) return false;
        int wgid = (int)L; { const int q = nwg / NXCD, r = nwg % NXCD, xcd = wgid % NXCD, off = wgid / NXCD; wgid = (xcd < r ? xcd * (q + 1) : r * (q + 1) + (xcd - r) * q) + off; }
        const int nig = WGM * nN, gid = wgid / nig, fm = gid * WGM, gsz = (nM - fm) < WGM ? (nM - fm) : WGM;
        u.pm = fm + ((wgid % nig) % gsz); u.pn = (wgid % nig) / gsz; return true;
    }
    __device__ __forceinline__ void a_ready(const Unit&) const {}
    __device__ __forceinline__ void done(const Unit&) const {}
};

__device__ __forceinline__ unsigned cvt_pk_bf16(float lo, float hi) { unsigned r; asm volatile("v_cvt_pk_bf16_f32 %0, %1, %2" : "=v"(r) : "v"(lo), "v"(hi)); return r; }

struct EpiU0 {
    static constexpr bool PERM = true, AFTER_DRAIN = false, MIDK = false;
    bf16_t* U; float* SM; int midk_t, pad;
    __device__ __forceinline__ void midk(f32x4 (&)[2][2][4][2], const Unit&, int, int) const {}
    __device__ __forceinline__ void operator()(const f32x4 (&acc)[2][2][4][2], const Unit& u, int wr, int wc, int fr, int fq) const {
        const int row0 = u.pm * BM + wr * 64 + fr;
        if (u.pn < 21) {
            const int col0 = u.pn * BM + wc * 32 + 8 * fq;
#pragma unroll
            for (int ai = 0; ai < 2; ++ai)
#pragma unroll
                for (int m = 0; m < 4; ++m) { bf16_t* rowp = U + (size_t)(row0 + ai * HALF + m * 16) * 5376 + col0;
#pragma unroll
                    for (int bj = 0; bj < 2; ++bj) { const f32x4 v0 = acc[ai][bj][m][0], v1 = acc[ai][bj][m][1];
                        u32x4 w; w.x = cvt_pk_bf16(v0[0], v0[1]); w.y = cvt_pk_bf16(v0[2], v0[3]); w.z = cvt_pk_bf16(v1[0], v1[1]); w.w = cvt_pk_bf16(v1[2], v1[3]);
                        *(u32x4*)(rowp + bj * HALF) = w; } }
        } else if (wc == 0) {
#pragma unroll
            for (int ai = 0; ai < 2; ++ai)
#pragma unroll
                for (int m = 0; m < 4; ++m) { float* rp = SM + (size_t)(row0 + ai * HALF + m * 16) * 32 + 8 * fq;
                    *(f32x4*)rp = acc[ai][0][m][0]; *(f32x4*)(rp + 4) = acc[ai][0][m][1]; }
        }
    }
};
template <bool SCALE> struct EpiRes {
    static constexpr bool PERM = false, AFTER_DRAIN = false, MIDK = SCALE;
    const float* base; float* out; const float* ssq; int midk_t, pad;
    __device__ __forceinline__ void midk(f32x4 (&acc)[2][2][4][2], const Unit& u, int wr, int fr) const {
#pragma unroll
        for (int ai = 0; ai < 2; ++ai)
#pragma unroll
            for (int m = 0; m < 4; ++m) { const float s = __builtin_amdgcn_rsqf(ssq[u.pm * BM + ai * HALF + wr * 64 + m * 16 + fr] * (1.0f / 1024.0f) + 1e-6f);
#pragma unroll
                for (int bj = 0; bj < 2; ++bj)
#pragma unroll
                    for (int n = 0; n < 2; ++n) acc[ai][bj][m][n] *= s;
                asm volatile("" ::: "memory"); }
    }
    __device__ __forceinline__ void operator()(const f32x4 (&acc)[2][2][4][2], const Unit& u, int wr, int wc, int fr, int fq) const {
        const int col0 = u.pn * BM + wc * 32 + 4 * fq;
#pragma unroll
        for (int ai = 0; ai < 2; ++ai)
#pragma unroll
            for (int m = 0; m < 4; ++m) { const size_t off = (size_t)(u.pm * BM + ai * HALF + wr * 64 + m * 16 + fr) * 1024 + col0;
#pragma unroll
                for (int bj = 0; bj < 2; ++bj)
#pragma unroll
                    for (int n = 0; n < 2; ++n) { const f32x4 b = *(const f32x4*)(base + off + bj * HALF + n * 16); *(f32x4*)(out + off + bj * HALF + n * 16) = b + acc[ai][bj][m][n]; } }
    }
};
struct EpiU1 {
    static constexpr bool PERM = true, AFTER_DRAIN = false, MIDK = false;
    bf16_t* U; float* ksum; float qscale; int midk_t;
    __device__ __forceinline__ void midk(f32x4 (&)[2][2][4][2], const Unit&, int, int) const {}
    __device__ __forceinline__ void operator()(const f32x4 (&acc)[2][2][4][2], const Unit& u, int wr, int wc, int fr, int fq) const {
        const int row0 = u.pm * BM + wr * 64 + fr, col0 = u.pn * BM + wc * 32 + 8 * fq;
        const int kind = u.pn >> 2;
        const float sc = (kind == 0) ? qscale : 1.f;
#pragma unroll
        for (int ai = 0; ai < 2; ++ai)
#pragma unroll
            for (int m = 0; m < 4; ++m) { bf16_t* rowp = U + (size_t)(row0 + ai * HALF + m * 16) * 4096 + col0;
#pragma unroll
                for (int bj = 0; bj < 2; ++bj) { f32x4 v0 = acc[ai][bj][m][0] * sc, v1 = acc[ai][bj][m][1] * sc;
                    if (kind == 3) {
#pragma unroll
                        for (int i = 0; i < 4; ++i) { v0[i] = v0[i] * __builtin_amdgcn_rcpf(1.f + __builtin_amdgcn_exp2f(-1.4426950408889634f * v0[i])); v1[i] = v1[i] * __builtin_amdgcn_rcpf(1.f + __builtin_amdgcn_exp2f(-1.4426950408889634f * v1[i])); } }
                    u32x4 w; w.x = cvt_pk_bf16(v0[0], v0[1]); w.y = cvt_pk_bf16(v0[2], v0[3]); w.z = cvt_pk_bf16(v1[0], v1[1]); w.w = cvt_pk_bf16(v1[2], v1[3]);
                    *(u32x4*)(rowp + bj * HALF) = w; } }
        if (kind == 1) {
            float* kp = ksum + (size_t)u.pm * 1024 + (col0 - 1024);
#pragma unroll
            for (int bj = 0; bj < 2; ++bj)
#pragma unroll
                for (int n = 0; n < 2; ++n) { f32x4 s = (f32x4){0.f, 0.f, 0.f, 0.f};
#pragma unroll
                    for (int ai = 0; ai < 2; ++ai)
#pragma unroll
                        for (int m = 0; m < 4; ++m) s += acc[ai][bj][m][n];
#pragma unroll
                    for (int i = 0; i < 4; ++i) { float t = s[i]; t += __shfl_xor(t, 1); t += __shfl_xor(t, 2); t += __shfl_xor(t, 4); t += __shfl_xor(t, 8); s[i] = t; }
                    if (fr == 0) {
#pragma unroll
                        for (int i = 0; i < 4; ++i) atomicAdd(kp + bj * HALF + 4 * n + i, s[i]); } }
        }
    }
};
template <class Epi, class Sched, bool ALIGN_EPI = false, bool SP2 = false>
__device__ __forceinline__ void gemm_phase(PG8_LAS unsigned char* lds, const Gemm g, const Sched& S, const Epi& E) {
    int tid_ = threadIdx.x; asm volatile("" : "+v"(tid_));
    const int tid = tid_, wid = __builtin_amdgcn_readfirstlane(tid >> 6), lane = tid & 63, wr = wid >> 2, wc = wid & 3, fr = lane & 15, fq = lane >> 4;
    const int K = g.K, nt = K / BK;
    unsigned voffA[2], voffB[2];
#pragma unroll
    for (int i = 0; i < 2; ++i) { int R, C; stage_rc(tid * 16 + i * 8192, R, C); const int Rb = Epi::PERM ? ((R & ~31) + perm32(R & 31)) : R;
        voffA[i] = (unsigned)(R * K + C) * 2u; voffB[i] = (unsigned)(Rb * K + C) * 2u; }
    const size_t kstep = (size_t)(BK * 2);
    const size_t hstep = (size_t)HALF * K * 2;
    const size_t tstep = 2 * hstep;
    const unsigned ldsw = (unsigned)wid * 1024u;
    const int aoff = lds_byte(wr * 64 + fr, fq * 8), boff = lds_byte(wc * 32 + fr, fq * 8);
#define PG8_SA(b, h) (((b) * 2 + (h)) * HTB)
#define PG8_SB(b, h) ((4 + (b) * 2 + (h)) * HTB)
#define PG8_STAGE(bufoff, gbase, voff) do { _Pragma("unroll") for (int _i = 0; _i < 2; ++_i) \
        __builtin_amdgcn_global_load_lds((const unsigned*)((const char*)(gbase) + (voff)[_i]), (PG8_LAS unsigned*)(lds + (bufoff) + ldsw + _i * 8192), 16, 0, 0); } while (0)
#define PG8_LDA(dst, b, h) do { _Pragma("unroll") for (int m = 0; m < 4; ++m) _Pragma("unroll") for (int k = 0; k < 2; ++k) dst[m][k] = *(const PG8_LAS bf16x8*)(lds + PG8_SA(b, h) + aoff + m * 2048 + k * 1024); } while (0)
#define PG8_LDB(dst, b, h) do { _Pragma("unroll") for (int n = 0; n < 2; ++n) _Pragma("unroll") for (int k = 0; k < 2; ++k) dst[n][k] = *(const PG8_LAS bf16x8*)(lds + PG8_SB(b, h) + boff + n * 2048 + k * 1024); } while (0)
#define PG8_MMA(ai, bj, At, Bt) do { __builtin_amdgcn_s_setprio(1); _Pragma("unroll") for (int m = 0; m < 4; ++m) _Pragma("unroll") for (int n = 0; n < 2; ++n) _Pragma("unroll") for (int k = 0; k < 2; ++k) \
        acc[ai][bj][m][n] = __builtin_amdgcn_mfma_f32_16x16x32_bf16(Bt[n][k], At[m][k], acc[ai][bj][m][n], 0, 0, 0); __builtin_amdgcn_s_setprio(0); } while (0)
#define PG8_WAIT_V(n) asm volatile("s_waitcnt vmcnt(" #n ")" ::: "memory")
#define PG8_WAIT_L(n) asm volatile("s_waitcnt lgkmcnt(" #n ")" ::: "memory")
#define PG8_BAR __builtin_amdgcn_s_barrier()
#define PG8_SCHED __builtin_amdgcn_sched_barrier(0)
    Unit cur, nxt; int ui = 0;
    if (!S.next(0, cur)) return;
    f32x4 acc[2][2][4][2];
#pragma unroll
    for (int a = 0; a < 2; ++a)
#pragma unroll
        for (int b = 0; b < 2; ++b)
#pragma unroll
            for (int m = 0; m < 4; ++m)
#pragma unroll
                for (int n = 0; n < 2; ++n) acc[a][b][m][n] = (f32x4){0.f, 0.f, 0.f, 0.f};
    bf16x8 At[4][2], B0[2][2], B1[2][2];
    const char* cA = (const char*)g.A + (size_t)cur.pm * tstep; const char* cB = (const char*)g.Bt + (size_t)cur.pn * tstep;
    S.a_ready(cur);
    if constexpr (SP2) {
        PG8_STAGE(PG8_SB(0, 0), cB, voffB); PG8_STAGE(PG8_SB(0, 1), cB + hstep, voffB); PG8_STAGE(PG8_SA(0, 0), cA, voffA); PG8_STAGE(PG8_SA(0, 1), cA + hstep, voffA);
        if (wr == 1) PG8_BAR;
        PG8_WAIT_V(2); PG8_BAR;
        PG8_STAGE(PG8_SB(1, 0), cB + kstep, voffB); PG8_STAGE(PG8_SA(1, 0), cA + kstep, voffA); PG8_STAGE(PG8_SB(1, 1), cB + hstep + kstep, voffB);
        PG8_WAIT_V(6); PG8_BAR;
    } else {
        PG8_STAGE(PG8_SB(0, 0), cB, voffB); PG8_STAGE(PG8_SA(0, 0), cA, voffA); PG8_STAGE(PG8_SB(0, 1), cB + hstep, voffB); PG8_STAGE(PG8_SA(0, 1), cA + hstep, voffA);
        if (wr == 1) PG8_BAR;
        PG8_WAIT_V(4); PG8_BAR;
        PG8_STAGE(PG8_SB(1, 0), cB + kstep, voffB); PG8_STAGE(PG8_SA(1, 0), cA + kstep, voffA); PG8_STAGE(PG8_SB(1, 1), cB + hstep + kstep, voffB);
        PG8_WAIT_V(6); PG8_BAR;
    }
    for (;;) {
        const bool has_next = S.next(ui + 1, nxt);
        const char* nA = has_next ? (const char*)g.A + (size_t)nxt.pm * tstep : cA; const char* nB = has_next ? (const char*)g.Bt + (size_t)nxt.pn * tstep : cB;
        for (int t = 0; t < nt; t += 2) {
            if constexpr (Epi::MIDK) { if (t == E.midk_t) E.midk(acc, cur, wr, fr); }
            const bool last = (t == nt - 2);
            const char* a1 = cA + (size_t)(t + 1) * kstep;
            const char* a2 = last ? nA : cA + (size_t)(t + 2) * kstep; const char* b2 = last ? nB : cB + (size_t)(t + 2) * kstep;
            const char* a3 = a2 + kstep; const char* b3 = b2 + kstep;
            if (last && has_next) S.a_ready(nxt);
            if constexpr (SP2) {
            PG8_LDB(B0, 0, 0); PG8_LDB(B1, 0, 1); PG8_SCHED; PG8_LDA(At, 0, 0); PG8_STAGE(PG8_SA(1, 1), a1 + hstep, voffA);
            PG8_WAIT_V(8); PG8_WAIT_L(0); PG8_BAR; PG8_MMA(0, 0, At, B0); PG8_MMA(0, 1, At, B1); PG8_BAR; PG8_SCHED;
            PG8_LDA(At, 0, 1); PG8_STAGE(PG8_SB(0, 0), b2, voffB); PG8_STAGE(PG8_SB(0, 1), b2 + hstep, voffB); PG8_STAGE(PG8_SA(0, 0), a2, voffA);
            PG8_WAIT_V(8); PG8_WAIT_L(0); PG8_BAR; PG8_MMA(1, 0, At, B0); PG8_MMA(1, 1, At, B1); PG8_BAR; PG8_SCHED;
            PG8_LDB(B0, 1, 0); PG8_LDB(B1, 1, 1); PG8_SCHED; PG8_LDA(At, 1, 0); PG8_STAGE(PG8_SA(0, 1), a2 + hstep, voffA);
            PG8_WAIT_V(8); PG8_WAIT_L(0); PG8_BAR; PG8_MMA(0, 0, At, B0); PG8_MMA(0, 1, At, B1); PG8_BAR; PG8_SCHED;
            PG8_LDA(At, 1, 1); PG8_STAGE(PG8_SB(1, 0), b3, voffB); PG8_STAGE(PG8_SB(1, 1), b3 + hstep, voffB); PG8_STAGE(PG8_SA(1, 0), a3, voffA);
            PG8_WAIT_V(8); PG8_WAIT_L(0); PG8_BAR; PG8_MMA(1, 0, At, B0); PG8_MMA(1, 1, At, B1); PG8_BAR; PG8_SCHED;
            } else {
            PG8_LDB(B0, 0, 0); PG8_SCHED; PG8_LDA(At, 0, 0); PG8_STAGE(PG8_SA(1, 1), a1 + hstep, voffA);
            PG8_WAIT_L(8); PG8_BAR; PG8_WAIT_L(0); PG8_MMA(0, 0, At, B0); PG8_BAR; PG8_SCHED;
            PG8_LDB(B1, 0, 1); PG8_STAGE(PG8_SB(0, 0), b2, voffB);
            PG8_BAR; PG8_WAIT_L(0); PG8_MMA(0, 1, At, B1); PG8_BAR;
            PG8_LDA(At, 0, 1); PG8_STAGE(PG8_SA(0, 0), a2, voffA);
            PG8_BAR; PG8_WAIT_L(0); PG8_MMA(1, 0, At, B0); PG8_BAR; PG8_SCHED;
            PG8_STAGE(PG8_SB(0, 1), b2 + hstep, voffB);
            PG8_WAIT_V(6); PG8_BAR; PG8_MMA(1, 1, At, B1); PG8_BAR;
            PG8_LDB(B0, 1, 0); PG8_SCHED; PG8_LDA(At, 1, 0); PG8_STAGE(PG8_SA(0, 1), a2 + hstep, voffA);
            PG8_WAIT_L(8); PG8_BAR; PG8_WAIT_L(0); PG8_MMA(0, 0, At, B0); PG8_BAR; PG8_SCHED;
            PG8_LDB(B1, 1, 1); PG8_STAGE(PG8_SB(1, 0), b3, voffB);
            PG8_BAR; PG8_WAIT_L(0); PG8_MMA(0, 1, At, B1); PG8_BAR;
            PG8_LDA(At, 1, 1); PG8_STAGE(PG8_SA(1, 0), a3, voffA);
            PG8_BAR; PG8_WAIT_L(0); PG8_MMA(1, 0, At, B0); PG8_BAR; PG8_SCHED;
            PG8_STAGE(PG8_SB(1, 1), b3 + hstep, voffB);
            PG8_WAIT_V(6); PG8_BAR; PG8_MMA(1, 1, At, B1); PG8_BAR;
            }
        }
        if constexpr (ALIGN_EPI) { if (wr == 0) PG8_BAR; }
        if constexpr (!Epi::AFTER_DRAIN) { E(acc, cur, wr, wc, fr, fq); S.done(cur); }
        if (!has_next) break;
#pragma unroll
        for (int a = 0; a < 2; ++a)
#pragma unroll
            for (int b = 0; b < 2; ++b)
#pragma unroll
                for (int m = 0; m < 4; ++m)
#pragma unroll
                    for (int n = 0; n < 2; ++n) acc[a][b][m][n] = (f32x4){0.f, 0.f, 0.f, 0.f};
        cur = nxt; cA = nA; cB = nB; ++ui;
        if constexpr (ALIGN_EPI) { if (wr == 1) PG8_BAR; }
    }
    PG8_WAIT_V(0);
    if constexpr (!ALIGN_EPI) { if (wr == 0) PG8_BAR; }
    PG8_BAR;
    if constexpr (Epi::AFTER_DRAIN) { E.fused(acc, cur, wr, wc, fr, fq, lds, wid, lane); S.done(cur); }
#undef PG8_SA
#undef PG8_SB
#undef PG8_STAGE
#undef PG8_LDA
#undef PG8_LDB
#undef PG8_MMA
#undef PG8_WAIT_V
#undef PG8_WAIT_L
#undef PG8_BAR
#undef PG8_SCHED
}
}
#define XB_TMO      128
#define XB_XCNT(j)  (256  + 64 * (j))
#define XB_XSUB(j)  (1280 + 64 * (j))
#define XB_XGEN(j)  (2304 + 64 * (j))
#define XB_TOP      3328
#define XB_TOPGEN   3392
#define XCD_BAR_WORDS 3456
#define XB_SPIN_CAP (1u << 18)

__device__ __forceinline__ unsigned xb_ld(unsigned* p)              { return __hip_atomic_load(p, __ATOMIC_RELAXED, __HIP_MEMORY_SCOPE_AGENT); }
__device__ __forceinline__ unsigned xb_add(unsigned* p, unsigned v) { return __hip_atomic_fetch_add(p, v, __ATOMIC_RELAXED, __HIP_MEMORY_SCOPE_AGENT); }
__device__ __forceinline__ unsigned xb_xcc_id() { return (unsigned)__builtin_amdgcn_s_getreg((3 << 11) | 20) & 0xFu; }
#define XB_SPIN(cond, bar) do { unsigned _sp = 0; while (cond) { __builtin_amdgcn_s_sleep(1); \
    if ((++_sp & 255u) == 0u) { if (xb_ld(&(bar)[XB_TMO])) break; if (_sp > XB_SPIN_CAP) { atomicAdd(&(bar)[XB_TMO], 1u); break; } } } } while (0)

struct XcdBarrier {
    unsigned* bar; unsigned x;
    volatile LAS unsigned* st;
};

__device__ __forceinline__ XcdBarrier xcd_barrier_post(unsigned* bar, volatile LAS unsigned* st) {
    XcdBarrier b; b.bar = bar; b.x = xb_xcc_id(); b.st = st;
    if (threadIdx.x == 0) (void)xb_add(&bar[XB_XCNT(b.x)], 1u);
    return b;
}
__device__ __forceinline__ void xcd_barrier_complete(unsigned* bar, unsigned x, unsigned& nloc, unsigned& nx) {
    const unsigned G = gridDim.x * gridDim.y * gridDim.z;
    unsigned sum, cnt, mine, sp = 0u;
    for (;;) {
        sum = 0u; cnt = 0u; mine = 0u;
#pragma unroll
        for (unsigned j = 0; j < 16; ++j) { const unsigned c = xb_ld(&bar[XB_XCNT(j)]); sum += c; cnt += (c > 0u) ? 1u : 0u; mine = (j == x) ? c : mine; }
        if (sum == G) break;
        __builtin_amdgcn_s_sleep(1);
        if ((++sp & 255u) == 0u) { if (xb_ld(&bar[XB_TMO])) break; if (sp > XB_SPIN_CAP) { atomicAdd(&bar[XB_TMO], 1u); break; } }
    }
    nloc = mine > 0u ? mine : 1u; nx = cnt > 0u ? cnt : 1u;
}

__device__ __forceinline__ void xcd_barrier(const XcdBarrier& b) {
    asm volatile("s_waitcnt vmcnt(0)" ::: "memory");
    __syncthreads();
    if (threadIdx.x == 0) {
        unsigned* bar = b.bar;
        __builtin_amdgcn_s_waitcnt(0);
        unsigned nloc = b.st[0], nx = b.st[1];
        if (nloc == 0u) { xcd_barrier_complete(bar, b.x, nloc, nx); b.st[0] = nloc; b.st[1] = nx; }
        const unsigned old = xb_add(&bar[XB_XSUB(b.x)], 1u);
        const unsigned gen = old / nloc;
        if (old + 1u == (gen + 1u) * nloc) {
            __builtin_amdgcn_fence(__ATOMIC_RELEASE, "agent");
            asm volatile("s_waitcnt vmcnt(0)" ::: "memory");
            const unsigned og = xb_add(&bar[XB_TOP], 1u);
            const unsigned tg = og / nx;
            if (og + 1u == (tg + 1u) * nx) xb_add(&bar[XB_TOPGEN], 1u);
            else XB_SPIN(xb_ld(&bar[XB_TOPGEN]) == tg, bar);
            __builtin_amdgcn_fence(__ATOMIC_ACQUIRE, "agent");
            xb_add(&bar[XB_XGEN(b.x)], 1u);
            asm volatile("s_waitcnt vmcnt(0)" ::: "memory");
        } else {
            XB_SPIN(xb_ld(&bar[XB_XGEN(b.x)]) == gen, bar);
            __builtin_amdgcn_fence(__ATOMIC_ACQUIRE, "agent");
            asm volatile("s_waitcnt vmcnt(0)" ::: "memory");
        }
    }
    __syncthreads();
}
template <int MAP> __device__ __forceinline__ int map_col(int n) {
    if (MAP == 0) return n;
    if (n < 2304) return n; if (n < 4352) return n + 16; if (n < 5376) return n + 32; if (n < 5392) return n - 5376 + 2304; if (n < 5408) return n - 5392 + 4368; return -1;
}
template <int MAP> __device__ __forceinline__ void transpose_item(const float* W, int K, int Nsrc, int Ndst, const float* kscale, int kscale_n, bf16_t* WT, LAS float* scr, int item, int lane) {
    const int nblk = Ndst / 32, kb = item / nblk, nb = item % nblk, k0 = 64 * kb, n0 = 32 * nb;
    const int sc = map_col<MAP>(n0 + (lane & 31));
#pragma unroll 8
    for (int i = 0; i < 32; ++i) { const int kk = 2 * i + (lane >> 5); float v = sc >= 0 ? W[(size_t)(k0 + kk) * Nsrc + sc] : 0.f; if (kscale && (k0 + kk) < kscale_n) v *= kscale[k0 + kk]; scr[kk * 33 + (lane & 31)] = v; }
    asm volatile("s_waitcnt lgkmcnt(0)" ::: "memory");
    const int c = lane & 7;
#pragma unroll
    for (int j = 0; j < 4; ++j) { const int n = (lane >> 3) + 8 * j; const LAS float* s = scr + (8 * c) * 33 + n;
        v4u o; o.x = pk2(s[0 * 33], s[1 * 33]); o.y = pk2(s[2 * 33], s[3 * 33]); o.z = pk2(s[4 * 33], s[5 * 33]); o.w = pk2(s[6 * 33], s[7 * 33]);
        *(v4u*)(WT + (size_t)(n0 + n) * K + k0 + 8 * c) = o; }
    asm volatile("s_waitcnt lgkmcnt(0)" ::: "memory");
}
__device__ __forceinline__ void rms_row_to_bf16(const float* xrow, const float* w, bf16_t* orow, int lane) {
    const v4f* xr = (const v4f*)xrow + lane; const v4f* wr = (const v4f*)w + lane;
    v4f v[4]; float s = 0.f;
#pragma unroll
    for (int j = 0; j < 4; ++j) { v[j] = xr[64 * j]; s += (v[j].x * v[j].x + v[j].y * v[j].y) + (v[j].z * v[j].z + v[j].w * v[j].w); }
    const float rstd = 1.0f / sqrtf(wave_sum(s) * (1.f / 1024.f) + RMS_EPS);
    unsigned long long* o8 = (unsigned long long*)orow + lane;
#pragma unroll
    for (int j = 0; j < 4; ++j) { const v4f ww = wr[64 * j]; o8[64 * j] = (unsigned long long)pk2(v[j].x * rstd * ww.x, v[j].y * rstd * ww.y) | ((unsigned long long)pk2(v[j].z * rstd * ww.z, v[j].w * rstd * ww.w) << 32); }
}
__device__ __forceinline__ void rms_row_f32(const float* xrow, const float* w, float* orow, int lane) {
    const v4f* xr = (const v4f*)xrow + lane; const v4f* wr = (const v4f*)w + lane;
    v4f v[4]; float s = 0.f;
#pragma unroll
    for (int j = 0; j < 4; ++j) { v[j] = xr[64 * j]; s += (v[j].x * v[j].x + v[j].y * v[j].y) + (v[j].z * v[j].z + v[j].w * v[j].w); }
    const float rstd = 1.0f / sqrtf(wave_sum(s) * (1.f / 1024.f) + RMS_EPS);
    v4f* o = (v4f*)orow + lane;
#pragma unroll
    for (int j = 0; j < 4; ++j) o[64 * j] = v[j] * rstd * wr[64 * j];
}

struct Params {
    const float *x, *even_norm, *even_w_in, *conv_w, *conv_b, *a_log, *dt_bias, *d_skip, *ssd_norm, *gate_w2, *gate_b, *gla_norm, *even_w_out, *odd_norm, *odd_w_in, *odd_w_out, *final_norm;
    float* out; unsigned char* ws;
};
#define WAVE_SYNC() do { asm volatile("s_waitcnt lgkmcnt(0)" ::: "memory"); __builtin_amdgcn_wave_barrier(); } while (0)

__device__ __forceinline__ void p0_phase(const Params& P, LAS unsigned char* lds, int gw, int NGW, int lane, int wave) {
    LAS float* scr = (LAS float*)lds + wave * 64 * 33;
    constexpr int I_A = (1024 / 64) * (N0 / 32), I_B = (2048 / 64) * (1024 / 32);
    for (int it = gw; it < I_A + I_B; it += NGW) {
        if (it < I_A) transpose_item<1>(P.even_w_in, 1024, 5408, N0, nullptr, 0, (bf16_t*)(P.ws + WS_BT0), scr, it, lane);
        else transpose_item<0>(P.even_w_out, 2048, 1024, 1024, P.ssd_norm, 1024, (bf16_t*)(P.ws + WS_BT1), scr, it - I_A, lane);
    }
    for (int m = gw; m < MTOK; m += NGW) rms_row_to_bf16(P.x + (size_t)m * 1024, P.even_norm, (bf16_t*)P.out + (size_t)m * 1024, lane);
}
__device__ __forceinline__ void p3b_phase(const Params& P, LAS unsigned char* lds, int gw, int NGW, int lane, int wave) {
    LAS float* scr = (LAS float*)lds + wave * 64 * 33;
    constexpr int I_A = (1024 / 64) * (4096 / 32), I_B = (1024 / 64) * (1024 / 32);
    for (int it = gw; it < I_A + I_B; it += NGW) {
        if (it < I_A) transpose_item<0>(P.odd_w_in, 1024, 4096, 4096, nullptr, 0, (bf16_t*)(P.ws + WS_BT2), scr, it, lane);
        else transpose_item<0>(P.odd_w_out, 1024, 1024, 1024, nullptr, 0, (bf16_t*)(P.ws + WS_BT3), scr, it - I_A, lane);
    }
    for (int m = gw; m < MTOK; m += NGW) rms_row_to_bf16(P.out + (size_t)m * 1024, P.odd_norm, (bf16_t*)(P.ws + WS_YG) + (size_t)m * 1024, lane);
}

__device__ __forceinline__ void ssd_naive_wave(const Params& P, int b, int hd, int p, LAS float* sB, LAS float* sC) {
    const bf16_t* U0 = (const bf16_t*)(P.ws + WS_U); const float* SM = (const float*)(P.ws + WS_SM);
    bf16_t* YG = (bf16_t*)(P.ws + WS_YG); float* ssq = (float*)(P.ws + WS_CTL + CTL_SSQ);
    const int g = hd / 8;
    const int cx = hd * 64 + p, cB = 1024 + g * 64 + p, cC = 1152 + g * 64 + p;
    float wx[4], wB[4], wC[4];
#pragma unroll
    for (int k = 0; k < 4; ++k) { wx[k] = P.conv_w[k * 1280 + cx]; wB[k] = P.conv_w[k * 1280 + cB]; wC[k] = P.conv_w[k * 1280 + cC]; }
    const float bx = P.conv_b[cx], bB = P.conv_b[cB], bC = P.conv_b[cC];
    const float a = -__expf(P.a_log[hd]), dtb = P.dt_bias[hd], Dk = P.d_skip[hd];
    float h[64];
#pragma unroll
    for (int n = 0; n < 64; ++n) h[n] = 0.f;
    float ux0 = 0.f, ux1 = 0.f, ux2 = 0.f, uB0 = 0.f, uB1 = 0.f, uB2 = 0.f, uC0 = 0.f, uC1 = 0.f, uC2 = 0.f;
    for (int t = 0; t < SEQ; ++t) {
        const size_t row = (size_t)b * SEQ + t;
        const bf16_t* ur = U0 + row * U0P + COL_XBC;
        const float x3 = bf2f(ur[cx]), b3 = bf2f(ur[cB]), c3 = bf2f(ur[cC]);
        const float xc = silu_f(bx + wx[0] * ux0 + wx[1] * ux1 + wx[2] * ux2 + wx[3] * x3);
        const float Bc = silu_f(bB + wB[0] * uB0 + wB[1] * uB1 + wB[2] * uB2 + wB[3] * b3);
        const float Cc = silu_f(bC + wC[0] * uC0 + wC[1] * uC1 + wC[2] * uC2 + wC[3] * c3);
        ux0 = ux1; ux1 = ux2; ux2 = x3; uB0 = uB1; uB1 = uB2; uB2 = b3; uC0 = uC1; uC1 = uC2; uC2 = c3;
        WAVE_SYNC();
        sB[p] = Bc; sC[p] = Cc;
        WAVE_SYNC();
        const float dt = softplus_f(SM[row * 32 + hd] + dtb), dA = __expf(dt * a), xdt = xc * dt;
        float y = 0.f;
#pragma unroll
        for (int n = 0; n < 64; ++n) { h[n] = dA * h[n] + xdt * sB[n]; y += sC[n] * h[n]; if ((n & 7) == 7) asm volatile("" ::: "memory"); }
        y += Dk * xc;
        const float z = bf2f(U0[row * U0P + COL_Z + cx]);
        const float yg = y * silu_f(z);
        YG[row * 2048 + cx] = (bf16_t)f2bf(yg);
        const float s = wave_sum(yg * yg);
        if (p == 0) atomicAdd(&ssq[row], s);
    }
}
__device__ __forceinline__ void gla_naive_wave(const Params& P, int b, int h, int l, LAS float* sq, LAS float* sk, LAS float* sd) {
    const bf16_t* U0 = (const bf16_t*)(P.ws + WS_U); const float* SM = (const float*)(P.ws + WS_SM);
    bf16_t* YG = (bf16_t*)(P.ws + WS_YG);
    float w2[16];
#pragma unroll
    for (int r = 0; r < 16; ++r) w2[r] = P.gate_w2[r * 512 + h * 64 + l];
    const float gb = P.gate_b[h * 64 + l], nw0 = P.gla_norm[l], nw1 = P.gla_norm[l + 64];
    float S0[64], S1[64];
#pragma unroll
    for (int d = 0; d < 64; ++d) { S0[d] = 0.f; S1[d] = 0.f; }
    for (int t = 0; t < SEQ; ++t) {
        const size_t row = (size_t)b * SEQ + t;
        const bf16_t* ur = U0 + row * U0P;
        float pre = gb;
#pragma unroll
        for (int r = 0; r < 16; ++r) pre += SM[row * 32 + 16 + r] * w2[r];
        const float dec = __expf(logsigmoid_f(pre) * (1.0f / 16.0f));
        WAVE_SYNC();
        sq[l] = bf2f(ur[COL_Q + h * 64 + l]) * 0.125f; sk[l] = bf2f(ur[COL_K + h * 64 + l]); sd[l] = dec;
        WAVE_SYNC();
        const float v0 = bf2f(ur[COL_V + h * 128 + l]), v1 = bf2f(ur[COL_V + h * 128 + 64 + l]);
        float o0 = 0.f, o1 = 0.f;
#pragma unroll
        for (int d = 0; d < 64; ++d) { const float dd = sd[d], kk = sk[d], qq = sq[d]; S0[d] = dd * S0[d] + kk * v0; S1[d] = dd * S1[d] + kk * v1; o0 += qq * S0[d]; o1 += qq * S1[d]; if ((d & 7) == 7) asm volatile("" ::: "memory"); }
        const float rstd = 1.0f / sqrtf(wave_sum(o0 * o0 + o1 * o1) * (1.0f / 128.0f) + RMS_EPS);
        const float g0 = bf2f(ur[COL_G + h * 128 + l]), g1 = bf2f(ur[COL_G + h * 128 + 64 + l]);
        YG[row * 2048 + 1024 + h * 128 + l] = (bf16_t)f2bf(o0 * rstd * nw0 * silu_f(g0));
        YG[row * 2048 + 1024 + h * 128 + 64 + l] = (bf16_t)f2bf(o1 * rstd * nw1 * silu_f(g1));
    }
}
__device__ __forceinline__ void moba_naive_row(const Params& P, int b, int h, int nb, int tr, const LAS float* skm) {
    const bf16_t* U1 = (const bf16_t*)(P.ws + WS_U);
    bf16_t* O = (bf16_t*)(P.ws + WS_YG + 32 * MiB);
    const int t = nb * 256 + tr; const size_t row = (size_t)b * SEQ + t;
    float q[64];
    { const bf16_t* qp = U1 + row * 4096 + h * 64;
#pragma unroll
      for (int d = 0; d < 64; ++d) q[d] = bf2f(qp[d]); }
    float gate[8];
#pragma unroll
    for (int j = 0; j < 8; ++j) { float s = 0.f;
#pragma unroll
        for (int d = 0; d < 64; ++d) s += q[d] * skm[j * 64 + d];
        gate[j] = s; }
    unsigned sel = 0;
#pragma unroll
    for (int j = 0; j < 8; ++j) { if (j < nb) { int rank = 0;
#pragma unroll
            for (int i = 0; i < 8; ++i) if (i < nb && (gate[i] > gate[j] || (gate[i] == gate[j] && i < j))) ++rank;
            if (rank < 3) sel |= 1u << j; } }
    float m = -1e30f, lsum = 0.f, o[64];
#pragma unroll
    for (int d = 0; d < 64; ++d) o[d] = 0.f;
    for (int jj = 0; jj <= nb; ++jj) {
        const int j = (jj == 0) ? nb : jj - 1;
        const bool own = (j == nb);
        const bool lane_on = own || ((sel >> j) & 1u);
        if (!__any(lane_on)) continue;
        for (int kk = 0; kk < 256; ++kk) {
            const int key = j * 256 + kk;
            const bool ok = lane_on && (!own || key <= t);
            if (!__any(ok)) { if (own) break; else continue; }
            const bf16_t* kp = U1 + ((size_t)b * SEQ + key) * 4096 + 1024 + h * 64;
            const bf16_t* vp = kp + 1024;
            float s = 0.f;
#pragma unroll
            for (int d = 0; d < 64; ++d) s += q[d] * bf2f(kp[d]);
            if (ok) {
                const float mn = fmaxf(m, s), f = __builtin_amdgcn_exp2f(m - mn), pr = __builtin_amdgcn_exp2f(s - mn);
                lsum = lsum * f + pr; m = mn;
#pragma unroll
                for (int d = 0; d < 64; ++d) o[d] = o[d] * f + pr * bf2f(vp[d]);
            }
        }
    }
    const float inv = 1.0f / lsum;
    const bf16_t* zp = U1 + row * 4096 + 3072 + h * 64; bf16_t* op = O + row * 1024 + h * 64;
#pragma unroll
    for (int d = 0; d < 64; ++d) op[d] = (bf16_t)f2bf(o[d] * inv * bf2f(zp[d]));
}

constexpr int RING_BYTES = 131072, LDSCTL_OFF = RING_BYTES, MISC_OFF = LDSCTL_OFF + 320, LDS_BYTES = 147456;
__global__ void __launch_bounds__(512, 2) mk_fwd(Params P) {
    extern __shared__ __attribute__((aligned(16))) unsigned char lds_raw[];
    LAS unsigned char* lds = (LAS unsigned char*)lds_raw;
    const int tid = threadIdx.x, lane = tid & 63, wave = __builtin_amdgcn_readfirstlane(tid >> 6);
    const int G = gridDim.x, gw = blockIdx.x * 8 + wave, NGW = G * 8;
    volatile LAS unsigned* MISC = (volatile LAS unsigned*)(lds + MISC_OFF);
    for (int u = tid; u < (LDS_BYTES - LDSCTL_OFF) / 4; u += 512) ((LAS unsigned*)(lds + LDSCTL_OFF))[u] = 0u;
    __syncthreads();
    unsigned char* ws = P.ws;
    XcdBarrier bar = xcd_barrier_post((unsigned*)(ws + WS_CTL + CTL_BAR), MISC + 8);

    p0_phase(P, lds, gw, NGW, lane, wave);
    xcd_barrier(bar);
    { pg8::Gemm g{(const bf16_t*)P.out, (const bf16_t*)(ws + WS_BT0), MTOK, N0, 1024, 0}; pg8::EpiU0 E{(bf16_t*)(ws + WS_U), (float*)(ws + WS_SM), -1, 0};
      pg8::StaticOrder S; S.init(MTOK, N0, G, (int)blockIdx.x);
#ifndef NO_G1
      pg8::gemm_phase<pg8::EpiU0, pg8::StaticOrder, true, true>(lds, g, S, E);
#endif
      }
    xcd_barrier(bar);
    if (wave == 0) {
        const int unit = blockIdx.x;
#ifndef NO_SSD
        if (unit < 128) ssd_naive_wave(P, unit / 16, unit % 16, lane, (LAS float*)lds, (LAS float*)lds + 64);
#endif
#ifndef NO_GLA
        if (unit >= 128 && unit < 192) gla_naive_wave(P, (unit - 128) / 8, (unit - 128) % 8, lane, (LAS float*)lds, (LAS float*)lds + 64, (LAS float*)lds + 128);
#endif
    }
    xcd_barrier(bar);
    { pg8::Gemm g{(const bf16_t*)(ws + WS_YG), (const bf16_t*)(ws + WS_BT1), MTOK, 1024, 2048, 0}; pg8::EpiRes<true> E{P.x, P.out, (const float*)(ws + WS_CTL + CTL_SSQ), 16, 0};
      pg8::StaticOrder S; S.init(MTOK, 1024, G, (int)blockIdx.x);
#ifndef NO_G2
      pg8::gemm_phase<pg8::EpiRes<true>, pg8::StaticOrder, true, true>(lds, g, S, E);
#endif
      }
    xcd_barrier(bar);
    p3b_phase(P, lds, gw, NGW, lane, wave);
    xcd_barrier(bar);
    { pg8::Gemm g{(const bf16_t*)(ws + WS_YG), (const bf16_t*)(ws + WS_BT2), MTOK, N1, 1024, 0}; pg8::EpiU1 E{(bf16_t*)(ws + WS_U), (float*)(ws + WS_CTL + CTL_KSUM), QK_C2, -1};
      pg8::StaticOrder S; S.init(MTOK, N1, G, (int)blockIdx.x);
#ifndef NO_G3
      pg8::gemm_phase<pg8::EpiU1, pg8::StaticOrder, true, true>(lds, g, S, E);
#endif
      }
    xcd_barrier(bar);
    for (int it = 0; it < (BATCH * 16 * 8) / (2 * G) + (((BATCH * 16 * 8) % (2 * G)) ? 1 : 0); ++it) {
        const int unit = (it * G + (int)blockIdx.x) * 2 + (tid >> 8);
        const bool live = unit < BATCH * 16 * 8;
        const int b = unit / 128, h = (unit / 8) % 16, nb = unit % 8;
        LAS float* skm = (LAS float*)lds + (tid >> 8) * 512;
        const float* ksum = (const float*)(ws + WS_CTL + CTL_KSUM);
        __syncthreads();
        if (live) for (int i = tid & 255; i < 512; i += 256) skm[i] = ksum[(size_t)(b * 8 + (i >> 6)) * 1024 + h * 64 + (i & 63)];
        __syncthreads();
#ifndef NO_MOBA
        if (live) moba_naive_row(P, b, h, nb, tid & 255, skm);
#endif
    }
    xcd_barrier(bar);
    { pg8::Gemm g{(const bf16_t*)(ws + WS_YG + 32 * MiB), (const bf16_t*)(ws + WS_BT3), MTOK, 1024, 1024, 0}; pg8::EpiRes<false> E{P.out, P.out, nullptr, -1, 0};
      pg8::StaticOrder S; S.init(MTOK, 1024, G, (int)blockIdx.x);
#ifndef NO_G4
      pg8::gemm_phase<pg8::EpiRes<false>, pg8::StaticOrder, true, true>(lds, g, S, E);
#endif
      }
    xcd_barrier(bar);
    for (int m = gw; m < MTOK; m += NGW) rms_row_f32(P.out + (size_t)m * 1024, P.final_norm, P.out + (size_t)m * 1024, lane);
}

extern "C" void kernel_launch(void* const* d_in, const int* in_sizes, int n_in, void* d_out, int out_size, void* d_ws, size_t ws_size, hipStream_t stream) {
    static int grid = 0;
    if (grid == 0) {
        if (n_in != 17 || in_sizes[0] != MTOK * DM || out_size != MTOK * DM || ws_size < WS_END) { fprintf(stderr, "kernel_launch: unexpected shapes (n_in %d, in0 %d, out %d, ws %zu)\n", n_in, n_in > 0 ? in_sizes[0] : -1, out_size, ws_size); grid = -1; return; }
        int dev = 0, cus = 0, per_cu = 0;
        if (hipGetDevice(&dev) != hipSuccess || hipDeviceGetAttribute(&cus, hipDeviceAttributeMultiprocessorCount, dev) != hipSuccess) { grid = -1; return; }
        if (hipFuncSetAttribute((const void*)mk_fwd, hipFuncAttributeMaxDynamicSharedMemorySize, LDS_BYTES) != hipSuccess) { fprintf(stderr, "kernel_launch: hipFuncSetAttribute failed\n"); grid = -1; return; }
        if (hipOccupancyMaxActiveBlocksPerMultiprocessor(&per_cu, (const void*)mk_fwd, 512, LDS_BYTES) != hipSuccess || per_cu < 1) { fprintf(stderr, "kernel_launch: occupancy query says %d blocks per CU\n", per_cu); }
        (void)hipGetLastError();
        grid = cus;
    }
    if (grid < 0) return;
    if (hipMemsetAsync((char*)d_ws + WS_CTL, 0, CTL_BYTES, stream) != hipSuccess) return;
    Params P{};
    const float** pp = (const float**)&P;
    for (int i = 0; i < 17; ++i) pp[i] = (const float*)d_in[i];
    P.out = (float*)d_out; P.ws = (unsigned char*)d_ws;
    hipLaunchKernelGGL(mk_fwd, dim3(grid), dim3(512), LDS_BYTES, stream, P);
}
```

```cpp
#include <hip/hip_runtime.h>
#include <cstdio>
#include <cstdint>

constexpr int BATCH = 8, SEQ = 2048, DM = 1024, MTOK = BATCH * SEQ;
constexpr int N0 = 5632, U0P = 5376;
constexpr int COL_Z = 0, COL_XBC = 1024, COL_Q = 2304, COL_K = 2816, COL_V = 3328, COL_G = 4352;
constexpr int N1 = 4096;
constexpr float RMS_EPS = 1e-6f;
constexpr float QK_C2 = 0.125f * 1.4426950408889634f;
constexpr size_t MiB = 1u << 20;
constexpr size_t WS_CTL = 0, CTL_BYTES = 2 * MiB;
constexpr size_t WS_BT0 = 2 * MiB;
constexpr size_t WS_BT2 = 2 * MiB, WS_BT3 = 10 * MiB;
constexpr size_t WS_BT1 = 13 * MiB;
constexpr size_t WS_SM = 17 * MiB;
constexpr size_t WS_U = 19 * MiB;
constexpr size_t WS_YG = 187 * MiB;
constexpr size_t WS_END = 251 * MiB;
constexpr size_t CTL_SSQ = 64 * 1024;
constexpr size_t CTL_KSUM = 256 * 1024;
constexpr size_t CTL_BAR = 1024 * 1024;

#define LAS __attribute__((address_space(3)))
typedef unsigned short bf16_t;
typedef unsigned v4u __attribute__((ext_vector_type(4)));
typedef unsigned v2u __attribute__((ext_vector_type(2)));
typedef float v4f __attribute__((ext_vector_type(4)));

__device__ __forceinline__ unsigned f2bf(float f) { unsigned u = __builtin_bit_cast(unsigned, f); return (u + 0x7fffu + ((u >> 16) & 1u)) >> 16; }
__device__ __forceinline__ unsigned pk2(float lo, float hi) { return f2bf(lo) | (f2bf(hi) << 16); }
__device__ __forceinline__ float bf2f(unsigned h) { return __builtin_bit_cast(float, h << 16); }
__device__ __forceinline__ float silu_f(float x) { return x / (1.f + __expf(-x)); }
__device__ __forceinline__ float softplus_f(float x) { return x > 20.f ? x : log1pf(__expf(x)); }
__device__ __forceinline__ float logsigmoid_f(float x) { return fminf(x, 0.f) - log1pf(__expf(-fabsf(x))); }
__device__ __forceinline__ float wave_sum(float v) {
#pragma unroll
    for (int o = 1; o < 64; o <<= 1) v += __shfl_xor(v, o);
    return v;
}
namespace pg8 {
#define PG8_LAS __attribute__((address_space(3)))
typedef unsigned short bf16_t;
typedef short bf16x8 __attribute__((ext_vector_type(8)));
typedef float f32x4 __attribute__((ext_vector_type(4)));
typedef unsigned u32x4 __attribute__((ext_vector_type(4)));
constexpr int BM = 256, BK = 64, HALF = 128, HTB = HALF * BK * 2  , STAGE_BYTES = 8 * HTB, NXCD = 8, WGM = 8;

__host__ __device__ __forceinline__ int lds_byte(int r, int c) { const int st = (r >> 4) * 2 + (c >> 5), rr = r & 15, cc = c & 31, ob = rr * 64 + cc * 2; return st * 1024 + (ob ^ (((ob >> 9) & 1) << 5)); }
__host__ __device__ __forceinline__ void stage_rc(int b, int& R, int& C) { const int st = b / 1024, sb = b % 1024, swz = sb ^ (((sb >> 9) & 1) << 5); R = (st >> 1) * 16 + swz / 64; C = (st & 1) * 32 + (swz % 64) / 2; }
__host__ __device__ __forceinline__ int perm32(int rho) { const int n = rho >> 4, i = rho & 15; return 8 * (i >> 2) + 4 * n + (i & 3); }

struct Unit { int pm, pn; };
struct Gemm { const bf16_t* A; const bf16_t* Bt; int M, N, K, pad; };

struct StaticOrder {
    int nM, nN, nwg, G, c;
    __host__ __device__ void init(int M, int N, int G_, int c_) { nM = M / BM; nN = N / BM; nwg = nM * nN; G = G_; c = c_; }
    __host__ __device__ bool next(int i, Unit& u) const {
        const long L = (long)i * G + c; if (L >= nwg) return false;
        int wgid = (int)L; { const int q = nwg / NXCD, r = nwg % NXCD, xcd = wgid % NXCD, off = wgid / NXCD; wgid = (xcd < r ? xcd * (q + 1) : r * (q + 1) + (xcd - r) * q) + off; }
        const int nig = WGM * nN, gid = wgid / nig, fm = gid * WGM, gsz = (nM - fm) < WGM ? (nM - fm) : WGM;
        u.pm = fm + ((wgid % nig) % gsz); u.pn = (wgid % nig) / gsz; return true;
    }
    __device__ __forceinline__ void a_ready(const Unit&) const {}
    __device__ __forceinline__ void done(const Unit&) const {}
};

__device__ __forceinline__ unsigned cvt_pk_bf16(float lo, float hi) { unsigned r; asm volatile("v_cvt_pk_bf16_f32 %0, %1, %2" : "=v"(r) : "v"(lo), "v"(hi)); return r; }

struct EpiU0 {
    static constexpr bool PERM = true, AFTER_DRAIN = false, MIDK = false;
    bf16_t* U; float* SM; int midk_t, pad;
    __device__ __forceinline__ void midk(f32x4 (&)[2][2][4][2], const Unit&, int, int) const {}
    __device__ __forceinline__ void operator()(const f32x4 (&acc)[2][2][4][2], const Unit& u, int wr, int wc, int fr, int fq) const {
        const int row0 = u.pm * BM + wr * 64 + fr;
        if (u.pn < 21) {
            const int col0 = u.pn * BM + wc * 32 + 8 * fq;
#pragma unroll
            for (int ai = 0; ai < 2; ++ai)
#pragma unroll
                for (int m = 0; m < 4; ++m) { bf16_t* rowp = U + (size_t)(row0 + ai * HALF + m * 16) * 5376 + col0;
#pragma unroll
                    for (int bj = 0; bj < 2; ++bj) { const f32x4 v0 = acc[ai][bj][m][0], v1 = acc[ai][bj][m][1];
                        u32x4 w; w.x = cvt_pk_bf16(v0[0], v0[1]); w.y = cvt_pk_bf16(v0[2], v0[3]); w.z = cvt_pk_bf16(v1[0], v1[1]); w.w = cvt_pk_bf16(v1[2], v1[3]);
                        *(u32x4*)(rowp + bj * HALF) = w; } }
        } else if (wc == 0) {
#pragma unroll
            for (int ai = 0; ai < 2; ++ai)
#pragma unroll
                for (int m = 0; m < 4; ++m) { float* rp = SM + (size_t)(row0 + ai * HALF + m * 16) * 32 + 8 * fq;
                    *(f32x4*)rp = acc[ai][0][m][0]; *(f32x4*)(rp + 4) = acc[ai][0][m][1]; }
        }
    }
};
template <bool SCALE> struct EpiRes {
    static constexpr bool PERM = false, AFTER_DRAIN = false, MIDK = SCALE;
    const float* base; float* out; const float* ssq; int midk_t, pad;
    __device__ __forceinline__ void midk(f32x4 (&acc)[2][2][4][2], const Unit& u, int wr, int fr) const {
#pragma unroll
        for (int ai = 0; ai < 2; ++ai)
#pragma unroll
            for (int m = 0; m < 4; ++m) { const float s = __builtin_amdgcn_rsqf(ssq[u.pm * BM + ai * HALF + wr * 64 + m * 16 + fr] * (1.0f / 1024.0f) + 1e-6f);
#pragma unroll
                for (int bj = 0; bj < 2; ++bj)
#pragma unroll
                    for (int n = 0; n < 2; ++n) acc[ai][bj][m][n] *= s;
                asm volatile("" ::: "memory"); }
    }
    __device__ __forceinline__ void operator()(const f32x4 (&acc)[2][2][4][2], const Unit& u, int wr, int wc, int fr, int fq) const {
        const int col0 = u.pn * BM + wc * 32 + 4 * fq;
#pragma unroll
        for (int ai = 0; ai < 2; ++ai)
#pragma unroll
            for (int m = 0; m < 4; ++m) { const size_t off = (size_t)(u.pm * BM + ai * HALF + wr * 64 + m * 16 + fr) * 1024 + col0;
#pragma unroll
                for (int bj = 0; bj < 2; ++bj)
#pragma unroll
                    for (int n = 0; n < 2; ++n) { const f32x4 b = *(const f32x4*)(base + off + bj * HALF + n * 16); *(f32x4*)(out + off + bj * HALF + n * 16) = b + acc[ai][bj][m][n]; } }
    }
};
struct EpiU1 {
    static constexpr bool PERM = true, AFTER_DRAIN = false, MIDK = false;
    bf16_t* U; float* ksum; float qscale; int midk_t;
    __device__ __forceinline__ void midk(f32x4 (&)[2][2][4][2], const Unit&, int, int) const {}
    __device__ __forceinline__ void operator()(const f32x4 (&acc)[2][2][4][2], const Unit& u, int wr, int wc, int fr, int fq) const {
        const int row0 = u.pm * BM + wr * 64 + fr, col0 = u.pn * BM + wc * 32 + 8 * fq;
        const int kind = u.pn >> 2;
        const float sc = (kind == 0) ? qscale : 1.f;
#pragma unroll
        for (int ai = 0; ai < 2; ++ai)
#pragma unroll
            for (int m = 0; m < 4; ++m) { bf16_t* rowp = U + (size_t)(row0 + ai * HALF + m * 16) * 4096 + col0;
#pragma unroll
                for (int bj = 0; bj < 2; ++bj) { f32x4 v0 = acc[ai][bj][m][0] * sc, v1 = acc[ai][bj][m][1] * sc;
                    if (kind == 3) {
#pragma unroll
                        for (int i = 0; i < 4; ++i) { v0[i] = v0[i] * __builtin_amdgcn_rcpf(1.f + __builtin_amdgcn_exp2f(-1.4426950408889634f * v0[i])); v1[i] = v1[i] * __builtin_amdgcn_rcpf(1.f + __builtin_amdgcn_exp2f(-1.4426950408889634f * v1[i])); } }
                    u32x4 w; w.x = cvt_pk_bf16(v0[0], v0[1]); w.y = cvt_pk_bf16(v0[2], v0[3]); w.z = cvt_pk_bf16(v1[0], v1[1]); w.w = cvt_pk_bf16(v1[2], v1[3]);
                    *(u32x4*)(rowp + bj * HALF) = w; } }
        if (kind == 1) {
            float* kp = ksum + (size_t)u.pm * 1024 + (col0 - 1024);
#pragma unroll
            for (int bj = 0; bj < 2; ++bj)
#pragma unroll
                for (int n = 0; n < 2; ++n) { f32x4 s = (f32x4){0.f, 0.f, 0.f, 0.f};
#pragma unroll
                    for (int ai = 0; ai < 2; ++ai)
#pragma unroll
                        for (int m = 0; m < 4; ++m) s += acc[ai][bj][m][n];
#pragma unroll
                    for (int i = 0; i < 4; ++i) { float t = s[i]; t += __shfl_xor(t, 1); t += __shfl_xor(t, 2); t += __shfl_xor(t, 4); t += __shfl_xor(t, 8); s[i] = t; }
                    if (fr == 0) {
#pragma unroll
                        for (int i = 0; i < 4; ++i) atomicAdd(kp + bj * HALF + 4 * n + i, s[i]); } }
        }
    }
};
template <class Epi, class Sched, bool ALIGN_EPI = false, bool SP2 = false>
__device__ __forceinline__ void gemm_phase(PG8_LAS unsigned char* lds, const Gemm g, const Sched& S, const Epi& E) {
    int tid_ = threadIdx.x; asm volatile("" : "+v"(tid_));
    const int tid = tid_, wid = __builtin_amdgcn_readfirstlane(tid >> 6), lane = tid & 63, wr = wid >> 2, wc = wid & 3, fr = lane & 15, fq = lane >> 4;
    const int K = g.K, nt = K / BK;
    unsigned voffA[2], voffB[2];
#pragma unroll
    for (int i = 0; i < 2; ++i) { int R, C; stage_rc(tid * 16 + i * 8192, R, C); const int Rb = Epi::PERM ? ((R & ~31) + perm32(R & 31)) : R;
        voffA[i] = (unsigned)(R * K + C) * 2u; voffB[i] = (unsigned)(Rb * K + C) * 2u; }
    const size_t kstep = (size_t)(BK * 2);
    const size_t hstep = (size_t)HALF * K * 2;
    const size_t tstep = 2 * hstep;
    const unsigned ldsw = (unsigned)wid * 1024u;
    const int aoff = lds_byte(wr * 64 + fr, fq * 8), boff = lds_byte(wc * 32 + fr, fq * 8);
#define PG8_SA(b, h) (((b) * 2 + (h)) * HTB)
#define PG8_SB(b, h) ((4 + (b) * 2 + (h)) * HTB)
#define PG8_STAGE(bufoff, gbase, voff) do { _Pragma("unroll") for (int _i = 0; _i < 2; ++_i) \
        __builtin_amdgcn_global_load_lds((const unsigned*)((const char*)(gbase) + (voff)[_i]), (PG8_LAS unsigned*)(lds + (bufoff) + ldsw + _i * 8192), 16, 0, 0); } while (0)
#define PG8_LDA(dst, b, h) do { _Pragma("unroll") for (int m = 0; m < 4; ++m) _Pragma("unroll") for (int k = 0; k < 2; ++k) dst[m][k] = *(const PG8_LAS bf16x8*)(lds + PG8_SA(b, h) + aoff + m * 2048 + k * 1024); } while (0)
#define PG8_LDB(dst, b, h) do { _Pragma("unroll") for (int n = 0; n < 2; ++n) _Pragma("unroll") for (int k = 0; k < 2; ++k) dst[n][k] = *(const PG8_LAS bf16x8*)(lds + PG8_SB(b, h) + boff + n * 2048 + k * 1024); } while (0)
#define PG8_MMA(ai, bj, At, Bt) do { __builtin_amdgcn_s_setprio(1); _Pragma("unroll") for (int m = 0; m < 4; ++m) _Pragma("unroll") for (int n = 0; n < 2; ++n) _Pragma("unroll") for (int k = 0; k < 2; ++k) \
        acc[ai][bj][m][n] = __builtin_amdgcn_mfma_f32_16x16x32_bf16(Bt[n][k], At[m][k], acc[ai][bj][m][n], 0, 0, 0); __builtin_amdgcn_s_setprio(0); } while (0)
#define PG8_WAIT_V(n) asm volatile("s_waitcnt vmcnt(" #n ")" ::: "memory")
#define PG8_WAIT_L(n) asm volatile("s_waitcnt lgkmcnt(" #n ")" ::: "memory")
#define PG8_BAR __builtin_amdgcn_s_barrier()
#define PG8_SCHED __builtin_amdgcn_sched_barrier(0)
    Unit cur, nxt; int ui = 0;
    if (!S.next(0, cur)) return;
    f32x4 acc[2][2][4][2];
#pragma unroll
    for (int a = 0; a < 2; ++a)
#pragma unroll
        for (int b = 0; b < 2; ++b)
#pragma unroll
            for (int m = 0; m < 4; ++m)
#pragma unroll
                for (int n = 0; n < 2; ++n) acc[a][b][m][n] = (f32x4){0.f, 0.f, 0.f, 0.f};
    bf16x8 At[4][2], B0[2][2], B1[2][2];
    const char* cA = (const char*)g.A + (size_t)cur.pm * tstep; const char* cB = (const char*)g.Bt + (size_t)cur.pn * tstep;
    S.a_ready(cur);
    if constexpr (SP2) {
        PG8_STAGE(PG8_SB(0, 0), cB, voffB); PG8_STAGE(PG8_SB(0, 1), cB + hstep, voffB); PG8_STAGE(PG8_SA(0, 0), cA, voffA); PG8_STAGE(PG8_SA(0, 1), cA + hstep, voffA);
        if (wr == 1) PG8_BAR;
        PG8_WAIT_V(2); PG8_BAR;
        PG8_STAGE(PG8_SB(1, 0), cB + kstep, voffB); PG8_STAGE(PG8_SA(1, 0), cA + kstep, voffA); PG8_STAGE(PG8_SB(1, 1), cB + hstep + kstep, voffB);
        PG8_WAIT_V(6); PG8_BAR;
    } else {
        PG8_STAGE(PG8_SB(0, 0), cB, voffB); PG8_STAGE(PG8_SA(0, 0), cA, voffA); PG8_STAGE(PG8_SB(0, 1), cB + hstep, voffB); PG8_STAGE(PG8_SA(0, 1), cA + hstep, voffA);
        if (wr == 1) PG8_BAR;
        PG8_WAIT_V(4); PG8_BAR;
        PG8_STAGE(PG8_SB(1, 0), cB + kstep, voffB); PG8_STAGE(PG8_SA(1, 0), cA + kstep, voffA); PG8_STAGE(PG8_SB(1, 1), cB + hstep + kstep, voffB);
        PG8_WAIT_V(6); PG8_BAR;
    }
    for (;;) {
        const bool has_next = S.next(ui + 1, nxt);
        const char* nA = has_next ? (const char*)g.A + (size_t)nxt.pm * tstep : cA; const char* nB = has_next ? (const char*)g.Bt + (size_t)nxt.pn * tstep : cB;
        for (int t = 0; t < nt; t += 2) {
            if constexpr (Epi::MIDK) { if (t == E.midk_t) E.midk(acc, cur, wr, fr); }
            const bool last = (t == nt - 2);
            const char* a1 = cA + (size_t)(t + 1) * kstep;
            const char* a2 = last ? nA : cA + (size_t)(t + 2) * kstep; const char* b2 = last ? nB : cB + (size_t)(t + 2) * kstep;
            const char* a3 = a2 + kstep; const char* b3 = b2 + kstep;
            if (last && has_next) S.a_ready(nxt);
            if constexpr (SP2) {
            PG8_LDB(B0, 0, 0); PG8_LDB(B1, 0, 1); PG8_SCHED; PG8_LDA(At, 0, 0); PG8_STAGE(PG8_SA(1, 1), a1 + hstep, voffA);
            PG8_WAIT_V(8); PG8_WAIT_L(0); PG8_BAR; PG8_MMA(0, 0, At, B0); PG8_MMA(0, 1, At, B1); PG8_BAR; PG8_SCHED;
            PG8_LDA(At, 0, 1); PG8_STAGE(PG8_SB(0, 0), b2, voffB); PG8_STAGE(PG8_SB(0, 1), b2 + hstep, voffB); PG8_STAGE(PG8_SA(0, 0), a2, voffA);
            PG8_WAIT_V(8); PG8_WAIT_L(0); PG8_BAR; PG8_MMA(1, 0, At, B0); PG8_MMA(1, 1, At, B1); PG8_BAR; PG8_SCHED;
            PG8_LDB(B0, 1, 0); PG8_LDB(B1, 1, 1); PG8_SCHED; PG8_LDA(At, 1, 0); PG8_STAGE(PG8_SA(0, 1), a2 + hstep, voffA);
            PG8_WAIT_V(8); PG8_WAIT_L(0); PG8_BAR; PG8_MMA(0, 0, At, B0); PG8_MMA(0, 1, At, B1); PG8_BAR; PG8_SCHED;
            PG8_LDA(At, 1, 1); PG8_STAGE(PG8_SB(1, 0), b3, voffB); PG8_STAGE(PG8_SB(1, 1), b3 + hstep, voffB); PG8_STAGE(PG8_SA(1, 0), a3, voffA);
            PG8_WAIT_V(8); PG8_WAIT_L(0); PG8_BAR; PG8_MMA(1, 0, At, B0); PG8_MMA(1, 1, At, B1); PG8_BAR; PG8_SCHED;
            } else {
            PG8_LDB(B0, 0, 0); PG8_SCHED; PG8_LDA(At, 0, 0); PG8_STAGE(PG8_SA(1, 1), a1 + hstep, voffA);
            PG8_WAIT_L(8); PG8_BAR; PG8_WAIT_L(0); PG8_MMA(0, 0, At, B0); PG8_BAR; PG8_SCHED;
            PG8_LDB(B1, 0, 1); PG8_STAGE(PG8_SB(0, 0), b2, voffB);
            PG8_BAR; PG8_WAIT_L(0); PG8_MMA(0, 1, At, B1); PG8_BAR;
            PG8_LDA(At, 0, 1); PG8_STAGE(PG8_SA(0, 0), a2, voffA);
            PG8_BAR; PG8_WAIT_L(0); PG8_MMA(1, 0, At, B0); PG8_BAR; PG8_SCHED;
            PG8_STAGE(PG8_SB(0, 1), b2 + hstep, voffB);
            PG8_WAIT_V(6); PG8_BAR; PG8_MMA(1, 1, At, B1); PG8_BAR;
            PG8_LDB(B0, 1, 0); PG8_SCHED; PG8_LDA(At, 1, 0); PG8_STAGE(PG8_SA(0, 1), a2 + hstep, voffA);
            PG8_WAIT_L(8); PG8_BAR; PG8_WAIT_L(0); PG8_MMA(0, 0, At, B0); PG8_BAR; PG8_SCHED;
            PG8_LDB(B1, 1, 1); PG8_STAGE(PG8_SB(1, 0), b3, voffB);
            PG8_BAR; PG8_WAIT_L(0); PG8_MMA(0, 1, At, B1); PG8_BAR;
            PG8_LDA(At, 1, 1); PG8_STAGE(PG8_SA(1, 0), a3, voffA);
            PG8_BAR; PG8_WAIT_L(0); PG8_MMA(1, 0, At, B0); PG8_BAR; PG8_SCHED;
            PG8_STAGE(PG8_SB(1, 1), b3 + hstep, voffB);
            PG8_WAIT_V(6); PG8_BAR; PG8_MMA(1, 1, At, B1); PG8_BAR;
            }
        }
        if constexpr (ALIGN_EPI) { if (wr == 0) PG8_BAR; }
        if constexpr (!Epi::AFTER_DRAIN) { E(acc, cur, wr, wc, fr, fq); S.done(cur); }
        if (!has_next) break;
#pragma unroll
        for (int a = 0; a < 2; ++a)
#pragma unroll
            for (int b = 0; b < 2; ++b)
#pragma unroll
                for (int m = 0; m < 4; ++m)
#pragma unroll
                    for (int n = 0; n < 2; ++n) acc[a][b][m][n] = (f32x4){0.f, 0.f, 0.f, 0.f};
        cur = nxt; cA = nA; cB = nB; ++ui;
        if constexpr (ALIGN_EPI) { if (wr == 1) PG8_BAR; }
    }
    PG8_WAIT_V(0);
    if constexpr (!ALIGN_EPI) { if (wr == 0) PG8_BAR; }
    PG8_BAR;
    if constexpr (Epi::AFTER_DRAIN) { E.fused(acc, cur, wr, wc, fr, fq, lds, wid, lane); S.done(cur); }
#undef PG8_SA
#undef PG8_SB
#undef PG8_STAGE
#undef PG8_LDA
#undef PG8_LDB
#undef PG8_MMA
#undef PG8_WAIT_V
#undef PG8_WAIT_L
#undef PG8_BAR
#undef PG8_SCHED
}
}
#define XB_TMO      128
#define XB_XCNT(j)  (256  + 64 * (j))
#define XB_XSUB(j)  (1280 + 64 * (j))
#define XB_XGEN(j)  (2304 + 64 * (j))
#define XB_TOP      3328
#define XB_TOPGEN   3392
#define XCD_BAR_WORDS 3456
#define XB_SPIN_CAP (1u << 18)

__device__ __forceinline__ unsigned xb_ld(unsigned* p)              { return __hip_atomic_load(p, __ATOMIC_RELAXED, __HIP_MEMORY_SCOPE_AGENT); }
__device__ __forceinline__ unsigned xb_add(unsigned* p, unsigned v) { return __hip_atomic_fetch_add(p, v, __ATOMIC_RELAXED, __HIP_MEMORY_SCOPE_AGENT); }
__device__ __forceinline__ unsigned xb_xcc_id() { return (unsigned)__builtin_amdgcn_s_getreg((3 << 11) | 20) & 0xFu; }
#define XB_SPIN(cond, bar) do { unsigned _sp = 0; while (cond) { __builtin_amdgcn_s_sleep(1); \
    if ((++_sp & 255u) == 0u) { if (xb_ld(&(bar)[XB_TMO])) break; if (_sp > XB_SPIN_CAP) { atomicAdd(&(bar)[XB_TMO], 1u); break; } } } } while (0)

struct XcdBarrier {
    unsigned* bar; unsigned x;
    volatile LAS unsigned* st;
};

__device__ __forceinline__ XcdBarrier xcd_barrier_post(unsigned* bar, volatile LAS unsigned* st) {
    XcdBarrier b; b.bar = bar; b.x = xb_xcc_id(); b.st = st;
    if (threadIdx.x == 0) (void)xb_add(&bar[XB_XCNT(b.x)], 1u);
    return b;
}
__device__ __forceinline__ void xcd_barrier_complete(unsigned* bar, unsigned x, unsigned& nloc, unsigned& nx) {
    const unsigned G = gridDim.x * gridDim.y * gridDim.z;
    unsigned sum, cnt, mine, sp = 0u;
    for (;;) {
        sum = 0u; cnt = 0u; mine = 0u;
#pragma unroll
        for (unsigned j = 0; j < 16; ++j) { const unsigned c = xb_ld(&bar[XB_XCNT(j)]); sum += c; cnt += (c > 0u) ? 1u : 0u; mine = (j == x) ? c : mine; }
        if (sum == G) break;
        __builtin_amdgcn_s_sleep(1);
        if ((++sp & 255u) == 0u) { if (xb_ld(&bar[XB_TMO])) break; if (sp > XB_SPIN_CAP) { atomicAdd(&bar[XB_TMO], 1u); break; } }
    }
    nloc = mine > 0u ? mine : 1u; nx = cnt > 0u ? cnt : 1u;
}

__device__ __forceinline__ void xcd_barrier(const XcdBarrier& b) {
    asm volatile("s_waitcnt vmcnt(0)" ::: "memory");
    __syncthreads();
    if (threadIdx.x == 0) {
        unsigned* bar = b.bar;
        __builtin_amdgcn_s_waitcnt(0);
        unsigned nloc = b.st[0], nx = b.st[1];
        if (nloc == 0u) { xcd_barrier_complete(bar, b.x, nloc, nx); b.st[0] = nloc; b.st[1] = nx; }
        const unsigned old = xb_add(&bar[XB_XSUB(b.x)], 1u);
        const unsigned gen = old / nloc;
        if (old + 1u == (gen + 1u) * nloc) {
            __builtin_amdgcn_fence(__ATOMIC_RELEASE, "agent");
            asm volatile("s_waitcnt vmcnt(0)" ::: "memory");
            const unsigned og = xb_add(&bar[XB_TOP], 1u);
            const unsigned tg = og / nx;
            if (og + 1u == (tg + 1u) * nx) xb_add(&bar[XB_TOPGEN], 1u);
            else XB_SPIN(xb_ld(&bar[XB_TOPGEN]) == tg, bar);
            __builtin_amdgcn_fence(__ATOMIC_ACQUIRE, "agent");
            xb_add(&bar[XB_XGEN(b.x)], 1u);
            asm volatile("s_waitcnt vmcnt(0)" ::: "memory");
        } else {
            XB_SPIN(xb_ld(&bar[XB_XGEN(b.x)]) == gen, bar);
            __builtin_amdgcn_fence(__ATOMIC_ACQUIRE, "agent");
            asm volatile("s_waitcnt vmcnt(0)" ::: "memory");
        }
    }
    __syncthreads();
}
template <int MAP> __device__ __forceinline__ int map_col(int n) {
    if (MAP == 0) return n;
    if (n < 2304) return n; if (n < 4352) return n + 16; if (n < 5376) return n + 32; if (n < 5392) return n - 5376 + 2304; if (n < 5408) return n - 5392 + 4368; return -1;
}
template <int MAP> __device__ __forceinline__ void transpose_item(const float* W, int K, int Nsrc, int Ndst, const float* kscale, int kscale_n, bf16_t* WT, LAS float* scr, int item, int lane) {
    const int nblk = Ndst / 32, kb = item / nblk, nb = item % nblk, k0 = 64 * kb, n0 = 32 * nb;
    const int sc = map_col<MAP>(n0 + (lane & 31));
#pragma unroll 8
    for (int i = 0; i < 32; ++i) { const int kk = 2 * i + (lane >> 5); float v = sc >= 0 ? W[(size_t)(k0 + kk) * Nsrc + sc] : 0.f; if (kscale && (k0 + kk) < kscale_n) v *= kscale[k0 + kk]; scr[kk * 33 + (lane & 31)] = v; }
    asm volatile("s_waitcnt lgkmcnt(0)" ::: "memory");
    const int c = lane & 7;
#pragma unroll
    for (int j = 0; j < 4; ++j) { const int n = (lane >> 3) + 8 * j; const LAS float* s = scr + (8 * c) * 33 + n;
        v4u o; o.x = pk2(s[0 * 33], s[1 * 33]); o.y = pk2(s[2 * 33], s[3 * 33]); o.z = pk2(s[4 * 33], s[5 * 33]); o.w = pk2(s[6 * 33], s[7 * 33]);
        *(v4u*)(WT + (size_t)(n0 + n) * K + k0 + 8 * c) = o; }
    asm volatile("s_waitcnt lgkmcnt(0)" ::: "memory");
}
__device__ __forceinline__ void rms_row_to_bf16(const float* xrow, const float* w, bf16_t* orow, int lane) {
    const v4f* xr = (const v4f*)xrow + lane; const v4f* wr = (const v4f*)w + lane;
    v4f v[4]; float s = 0.f;
#pragma unroll
    for (int j = 0; j < 4; ++j) { v[j] = xr[64 * j]; s += (v[j].x * v[j].x + v[j].y * v[j].y) + (v[j].z * v[j].z + v[j].w * v[j].w); }
    const float rstd = 1.0f / sqrtf(wave_sum(s) * (1.f / 1024.f) + RMS_EPS);
    unsigned long long* o8 = (unsigned long long*)orow + lane;
#pragma unroll
    for (int j = 0; j < 4; ++j) { const v4f ww = wr[64 * j]; o8[64 * j] = (unsigned long long)pk2(v[j].x * rstd * ww.x, v[j].y * rstd * ww.y) | ((unsigned long long)pk2(v[j].z * rstd * ww.z, v[j].w * rstd * ww.w) << 32); }
}
__device__ __forceinline__ void rms_row_f32(const float* xrow, const float* w, float* orow, int lane) {
    const v4f* xr = (const v4f*)xrow + lane; const v4f* wr = (const v4f*)w + lane;
    v4f v[4]; float s = 0.f;
#pragma unroll
    for (int j = 0; j < 4; ++j) { v[j] = xr[64 * j]; s += (v[j].x * v[j].x + v[j].y * v[j].y) + (v[j].z * v[j].z + v[j].w * v[j].w); }
    const float rstd = 1.0f / sqrtf(wave_sum(s) * (1.f / 1024.f) + RMS_EPS);
    v4f* o = (v4f*)orow + lane;
#pragma unroll
    for (int j = 0; j < 4; ++j) o[64 * j] = v[j] * rstd * wr[64 * j];
}

struct Params {
    const float *x, *even_norm, *even_w_in, *conv_w, *conv_b, *a_log, *dt_bias, *d_skip, *ssd_norm, *gate_w2, *gate_b, *gla_norm, *even_w_out, *odd_norm, *odd_w_in, *odd_w_out, *final_norm;
    float* out; unsigned char* ws;
};
#define WAVE_SYNC() do { asm volatile("s_waitcnt lgkmcnt(0)" ::: "memory"); __builtin_amdgcn_wave_barrier(); } while (0)

__device__ __forceinline__ void p0_phase(const Params& P, LAS unsigned char* lds, int gw, int NGW, int lane, int wave) {
    LAS float* scr = (LAS float*)lds + wave * 64 * 33;
    constexpr int I_A = (1024 / 64) * (N0 / 32), I_B = (2048 / 64) * (1024 / 32);
    for (int it = gw; it < I_A + I_B; it += NGW) {
        if (it < I_A) transpose_item<1>(P.even_w_in, 1024, 5408, N0, nullptr, 0, (bf16_t*)(P.ws + WS_BT0), scr, it, lane);
        else transpose_item<0>(P.even_w_out, 2048, 1024, 1024, P.ssd_norm, 1024, (bf16_t*)(P.ws + WS_BT1), scr, it - I_A, lane);
    }
    for (int m = gw; m < MTOK; m += NGW) rms_row_to_bf16(P.x + (size_t)m * 1024, P.even_norm, (bf16_t*)P.out + (size_t)m * 1024, lane);
}
__device__ __forceinline__ void p3b_phase(const Params& P, LAS unsigned char* lds, int gw, int NGW, int lane, int wave) {
    LAS float* scr = (LAS float*)lds + wave * 64 * 33;
    constexpr int I_A = (1024 / 64) * (4096 / 32), I_B = (1024 / 64) * (1024 / 32);
    for (int it = gw; it < I_A + I_B; it += NGW) {
        if (it < I_A) transpose_item<0>(P.odd_w_in, 1024, 4096, 4096, nullptr, 0, (bf16_t*)(P.ws + WS_BT2), scr, it, lane);
        else transpose_item<0>(P.odd_w_out, 1024, 1024, 1024, nullptr, 0, (bf16_t*)(P.ws + WS_BT3), scr, it - I_A, lane);
    }
    for (int m = gw; m < MTOK; m += NGW) rms_row_to_bf16(P.out + (size_t)m * 1024, P.odd_norm, (bf16_t*)(P.ws + WS_YG) + (size_t)m * 1024, lane);
}

__device__ __forceinline__ void ssd_naive_wave(const Params& P, int b, int hd, int p, LAS float* sB, LAS float* sC) {
    const bf16_t* U0 = (const bf16_t*)(P.ws + WS_U); const float* SM = (const float*)(P.ws + WS_SM);
    bf16_t* YG = (bf16_t*)(P.ws + WS_YG); float* ssq = (float*)(P.ws + WS_CTL + CTL_SSQ);
    const int g = hd / 8;
    const int cx = hd * 64 + p, cB = 1024 + g * 64 + p, cC = 1152 + g * 64 + p;
    float wx[4], wB[4], wC[4];
#pragma unroll
    for (int k = 0; k < 4; ++k) { wx[k] = P.conv_w[k * 1280 + cx]; wB[k] = P.conv_w[k * 1280 + cB]; wC[k] = P.conv_w[k * 1280 + cC]; }
    const float bx = P.conv_b[cx], bB = P.conv_b[cB], bC = P.conv_b[cC];
    const float a = -__expf(P.a_log[hd]), dtb = P.dt_bias[hd], Dk = P.d_skip[hd];
    float h[64];
#pragma unroll
    for (int n = 0; n < 64; ++n) h[n] = 0.f;
    float ux0 = 0.f, ux1 = 0.f, ux2 = 0.f, uB0 = 0.f, uB1 = 0.f, uB2 = 0.f, uC0 = 0.f, uC1 = 0.f, uC2 = 0.f;
    for (int t = 0; t < SEQ; ++t) {
        const size_t row = (size_t)b * SEQ + t;
        const bf16_t* ur = U0 + row * U0P + COL_XBC;
        const float x3 = bf2f(ur[cx]), b3 = bf2f(ur[cB]), c3 = bf2f(ur[cC]);
        const float xc = silu_f(bx + wx[0] * ux0 + wx[1] * ux1 + wx[2] * ux2 + wx[3] * x3);
        const float Bc = silu_f(bB + wB[0] * uB0 + wB[1] * uB1 + wB[2] * uB2 + wB[3] * b3);
        const float Cc = silu_f(bC + wC[0] * uC0 + wC[1] * uC1 + wC[2] * uC2 + wC[3] * c3);
        ux0 = ux1; ux1 = ux2; ux2 = x3; uB0 = uB1; uB1 = uB2; uB2 = b3; uC0 = uC1; uC1 = uC2; uC2 = c3;
        WAVE_SYNC();
        sB[p] = Bc; sC[p] = Cc;
        WAVE_SYNC();
        const float dt = softplus_f(SM[row * 32 + hd] + dtb), dA = __expf(dt * a), xdt = xc * dt;
        float y = 0.f;
#pragma unroll
        for (int n = 0; n < 64; ++n) { h[n] = dA * h[n] + xdt * sB[n]; y += sC[n] * h[n]; if ((n & 7) == 7) asm volatile("" ::: "memory"); }
        y += Dk * xc;
        const float z = bf2f(U0[row * U0P + COL_Z + cx]);
        const float yg = y * silu_f(z);
        YG[row * 2048 + cx] = (bf16_t)f2bf(yg);
        const float s = wave_sum(yg * yg);
        if (p == 0) atomicAdd(&ssq[row], s);
    }
}
__device__ __forceinline__ void gla_naive_wave(const Params& P, int b, int h, int l, LAS float* sq, LAS float* sk, LAS float* sd) {
    const bf16_t* U0 = (const bf16_t*)(P.ws + WS_U); const float* SM = (const float*)(P.ws + WS_SM);
    bf16_t* YG = (bf16_t*)(P.ws + WS_YG);
    float w2[16];
#pragma unroll
    for (int r = 0; r < 16; ++r) w2[r] = P.gate_w2[r * 512 + h * 64 + l];
    const float gb = P.gate_b[h * 64 + l], nw0 = P.gla_norm[l], nw1 = P.gla_norm[l + 64];
    float S0[64], S1[64];
#pragma unroll
    for (int d = 0; d < 64; ++d) { S0[d] = 0.f; S1[d] = 0.f; }
    for (int t = 0; t < SEQ; ++t) {
        const size_t row = (size_t)b * SEQ + t;
        const bf16_t* ur = U0 + row * U0P;
        float pre = gb;
#pragma unroll
        for (int r = 0; r < 16; ++r) pre += SM[row * 32 + 16 + r] * w2[r];
        const float dec = __expf(logsigmoid_f(pre) * (1.0f / 16.0f));
        WAVE_SYNC();
        sq[l] = bf2f(ur[COL_Q + h * 64 + l]) * 0.125f; sk[l] = bf2f(ur[COL_K + h * 64 + l]); sd[l] = dec;
        WAVE_SYNC();
        const float v0 = bf2f(ur[COL_V + h * 128 + l]), v1 = bf2f(ur[COL_V + h * 128 + 64 + l]);
        float o0 = 0.f, o1 = 0.f;
#pragma unroll
        for (int d = 0; d < 64; ++d) { const float dd = sd[d], kk = sk[d], qq = sq[d]; S0[d] = dd * S0[d] + kk * v0; S1[d] = dd * S1[d] + kk * v1; o0 += qq * S0[d]; o1 += qq * S1[d]; if ((d & 7) == 7) asm volatile("" ::: "memory"); }
        const float rstd = 1.0f / sqrtf(wave_sum(o0 * o0 + o1 * o1) * (1.0f / 128.0f) + RMS_EPS);
        const float g0 = bf2f(ur[COL_G + h * 128 + l]), g1 = bf2f(ur[COL_G + h * 128 + 64 + l]);
        YG[row * 2048 + 1024 + h * 128 + l] = (bf16_t)f2bf(o0 * rstd * nw0 * silu_f(g0));
        YG[row * 2048 + 1024 + h * 128 + 64 + l] = (bf16_t)f2bf(o1 * rstd * nw1 * silu_f(g1));
    }
}
__device__ __forceinline__ void moba_naive_row(const Params& P, int b, int h, int nb, int tr, const LAS float* skm) {
    const bf16_t* U1 = (const bf16_t*)(P.ws + WS_U);
    bf16_t* O = (bf16_t*)(P.ws + WS_YG + 32 * MiB);
    const int t = nb * 256 + tr; const size_t row = (size_t)b * SEQ + t;
    float q[64];
    { const bf16_t* qp = U1 + row * 4096 + h * 64;
#pragma unroll
      for (int d = 0; d < 64; ++d) q[d] = bf2f(qp[d]); }
    float gate[8];
#pragma unroll
    for (int j = 0; j < 8; ++j) { float s = 0.f;
#pragma unroll
        for (int d = 0; d < 64; ++d) s += q[d] * skm[j * 64 + d];
        gate[j] = s; }
    unsigned sel = 0;
#pragma unroll
    for (int j = 0; j < 8; ++j) { if (j < nb) { int rank = 0;
#pragma unroll
            for (int i = 0; i < 8; ++i) if (i < nb && (gate[i] > gate[j] || (gate[i] == gate[j] && i < j))) ++rank;
            if (rank < 3) sel |= 1u << j; } }
    float m = -1e30f, lsum = 0.f, o[64];
#pragma unroll
    for (int d = 0; d < 64; ++d) o[d] = 0.f;
    for (int jj = 0; jj <= nb; ++jj) {
        const int j = (jj == 0) ? nb : jj - 1;
        const bool own = (j == nb);
        const bool lane_on = own || ((sel >> j) & 1u);
        if (!__any(lane_on)) continue;
        for (int kk = 0; kk < 256; ++kk) {
            const int key = j * 256 + kk;
            const bool ok = lane_on && (!own || key <= t);
            if (!__any(ok)) { if (own) break; else continue; }
            const bf16_t* kp = U1 + ((size_t)b * SEQ + key) * 4096 + 1024 + h * 64;
            const bf16_t* vp = kp + 1024;
            float s = 0.f;
#pragma unroll
            for (int d = 0; d < 64; ++d) s += q[d] * bf2f(kp[d]);
            if (ok) {
                const float mn = fmaxf(m, s), f = __builtin_amdgcn_exp2f(m - mn), pr = __builtin_amdgcn_exp2f(s - mn);
                lsum = lsum * f + pr; m = mn;
#pragma unroll
                for (int d = 0; d < 64; ++d) o[d] = o[d] * f + pr * bf2f(vp[d]);
            }
        }
    }
    const float inv = 1.0f / lsum;
    const bf16_t* zp = U1 + row * 4096 + 3072 + h * 64; bf16_t* op = O + row * 1024 + h * 64;
#pragma unroll
    for (int d = 0; d < 64; ++d) op[d] = (bf16_t)f2bf(o[d] * inv * bf2f(zp[d]));
}

namespace moba {
typedef short bf16x8 __attribute__((ext_vector_type(8)));
typedef short s16x4 __attribute__((ext_vector_type(4)));
typedef float f32x16 __attribute__((ext_vector_type(16)));
typedef float f32x2_t __attribute__((ext_vector_type(2)));
typedef __bf16 bf16x2_t __attribute__((ext_vector_type(2)));
typedef short v4i16_t __attribute__((ext_vector_type(4)));
typedef const LAS char* lds_cptr;
__device__ __forceinline__ int crow(int r, int hi) { return (r & 3) + 8 * (r >> 2) + 4 * hi; }
__device__ __forceinline__ unsigned cvtpk(float lo, float hi) { f32x2_t v = {lo, hi}; bf16x2_t b = __builtin_convertvector(v, bf16x2_t); return __builtin_bit_cast(unsigned, b); }
__device__ __forceinline__ s16x4 vtr(lds_cptr p) { return __builtin_bit_cast(s16x4, __builtin_amdgcn_ds_read_tr16_b64_v4i16((LAS v4i16_t*)p)); }
constexpr int L_K = 0, L_V = 16384, L_KS = 32768, L_BYTES = 32768 + 2048;

__device__ __forceinline__ void unit(const Params& P, int b, int h, int nb, LAS unsigned char* lds) {
    int tid_ = threadIdx.x; asm volatile("" : "+v"(tid_));
    const int tid = tid_, lane = tid & 63, r32 = lane & 31, hi = lane >> 5, wid = __builtin_amdgcn_readfirstlane(tid >> 6);
    const bf16_t* U1 = (const bf16_t*)(P.ws + WS_U);
    const size_t rowbase = (size_t)b * SEQ; const int q0 = nb * 256;
    { const float* ksum = (const float*)(P.ws + WS_CTL + CTL_KSUM); LAS float* sk = (LAS float*)(lds + L_KS);
      sk[tid] = ksum[(size_t)(b * 8 + (tid >> 6)) * 1024 + h * 64 + (tid & 63)]; }
    const bf16_t* ksrc0 = U1 + (rowbase + lane) * 4096 + 1024 + h * 64 + wid * 8;
    const bf16_t* vsrc0 = U1 + (rowbase + 16 * (wid & 3) + (lane >> 2)) * 4096 + 2048 + h * 64 + (wid >> 2) * 32 + (lane & 3) * 8;
    const int stoff = wid * 1024 + lane * 16;
    const int NT = 4 * (nb + 1);
#define MOBA_TILE_ROW(s) (((s) < 4) ? (q0 + (s) * 64) : ((((s) - 4) >> 2) * 256 + (((s) - 4) & 3) * 64))
    v4u kreg, vreg;
    { const size_t ro = (size_t)MOBA_TILE_ROW(0) * 4096; kreg = *(const v4u*)(ksrc0 + ro); vreg = *(const v4u*)(vsrc0 + ro); }
    const bf16_t* Qw = U1 + (rowbase + q0 + wid * 32 + r32) * 4096 + h * 64;
    bf16x8 qr[4];
#pragma unroll
    for (int d0 = 0; d0 < 4; ++d0) qr[d0] = *(const bf16x8*)(Qw + d0 * 16 + hi * 8);
    *(LAS v4u*)(lds + L_K + stoff) = kreg; *(LAS v4u*)(lds + L_V + stoff) = vreg;
    __syncthreads();
    unsigned sel = 0;
    if (nb > 0) {
        const LAS float* sk = (const LAS float*)(lds + L_KS);
        float gate[8];
#pragma unroll
        for (int j = 0; j < 7; ++j) { float s = 0.f;
            if (j < nb) {
#pragma unroll
                for (int d0 = 0; d0 < 4; ++d0)
#pragma unroll
                    for (int e = 0; e < 8; ++e) s += bf2f((unsigned short)qr[d0][e]) * sk[j * 64 + d0 * 16 + hi * 8 + e];
                s += __shfl_xor(s, 32); }
            gate[j] = s; }
        gate[7] = 0.f;
#pragma unroll
        for (int j = 0; j < 7; ++j) { if (j < nb) { int rank = 0;
#pragma unroll
                for (int i = 0; i < 7; ++i) if (i < nb && (gate[i] > gate[j] || (gate[i] == gate[j] && i < j))) ++rank;
                if (rank < 3) sel |= 1u << j; } }
    }
    float m = -INFINITY, l = 0.f; f32x16 o0 = {}, o1 = {};
    const int qloc = wid * 32 + r32;
    const lds_cptr vp0 = (lds_cptr)lds + L_V + ((lane >> 4) & 1) * 32 + (lane & 3) * 8 + (4 * hi + ((lane & 15) >> 2)) * 64;
    const lds_cptr kp0 = (lds_cptr)lds + L_K + hi * 1024 + r32 * 16;
    for (int s = 0; s < NT; ++s) {
        const bool has_next = (s + 1) < NT;
        if (has_next) { const size_t ro = (size_t)MOBA_TILE_ROW(s + 1) * 4096; kreg = *(const v4u*)(ksrc0 + ro); vreg = *(const v4u*)(vsrc0 + ro); }
        const bool own = s < 4; const int kt = own ? s : ((s - 4) & 3); const int jb = own ? nb : ((s - 4) >> 2);
        const bool lane_on = own || ((sel >> jb) & 1u);
        const bool active = own ? (kt * 64 <= wid * 32 + 31) : (__any(lane_on) != 0);
        if (active) {
            const lds_cptr kp = kp0 + (s & 1) * 8192; const lds_cptr vp = vp0 + (s & 1) * 8192;
            f32x16 p0 = {}, p1 = {};
#pragma unroll
            for (int d0 = 0; d0 < 4; ++d0) {
                const bf16x8 k0 = *(const LAS bf16x8*)(kp + d0 * 2048), k1 = *(const LAS bf16x8*)(kp + d0 * 2048 + 512);
                p0 = __builtin_amdgcn_mfma_f32_32x32x16_bf16(k0, qr[d0], p0, 0, 0, 0);
                p1 = __builtin_amdgcn_mfma_f32_32x32x16_bf16(k1, qr[d0], p1, 0, 0, 0); }
            if (own && kt == (wid >> 1)) {
#pragma unroll
                for (int r = 0; r < 16; ++r) { const int key = kt * 64 + crow(r, hi); if (key > qloc) p0[r] = -INFINITY; if (key + 32 > qloc) p1[r] = -INFINITY; }
            }
            if (!own) {
#pragma unroll
                for (int r = 0; r < 16; ++r) { p0[r] = lane_on ? p0[r] : -INFINITY; p1[r] = lane_on ? p1[r] : -INFINITY; }
            }
            float rm = fmaxf(p0[0], p1[0]);
#pragma unroll
            for (int r = 1; r < 16; ++r) rm = fmaxf(rm, fmaxf(p0[r], p1[r]));
            rm = fmaxf(rm, __shfl_xor(rm, 32));
            const float mn = fmaxf(m, rm), alpha = __builtin_amdgcn_exp2f(m - mn);
            m = mn;
            float rs = 0.f;
#pragma unroll
            for (int r = 0; r < 16; ++r) { p0[r] = __builtin_amdgcn_exp2f(p0[r] - mn); p1[r] = __builtin_amdgcn_exp2f(p1[r] - mn); rs += p0[r] + p1[r]; }
            rs += __shfl_xor(rs, 32);
            l = l * alpha + rs;
#pragma unroll
            for (int r = 0; r < 16; ++r) { o0[r] *= alpha; o1[r] *= alpha; }
            v4u pw[4];
#pragma unroll
            for (int e = 0; e < 4; ++e) { pw[0][e] = cvtpk(p0[2 * e], p0[2 * e + 1]); pw[1][e] = cvtpk(p0[8 + 2 * e], p0[8 + 2 * e + 1]); pw[2][e] = cvtpk(p1[2 * e], p1[2 * e + 1]); pw[3][e] = cvtpk(p1[8 + 2 * e], p1[8 + 2 * e + 1]); }
#pragma unroll
            for (int ks = 0; ks < 4; ++ks) {
                const s16x4 a0 = vtr(vp + ks * 1024), a1 = vtr(vp + ks * 1024 + 512), c0 = vtr(vp + 4096 + ks * 1024), c1 = vtr(vp + 4096 + ks * 1024 + 512);
                const bf16x8 v0 = (bf16x8){a0[0], a0[1], a0[2], a0[3], a1[0], a1[1], a1[2], a1[3]}, v1 = (bf16x8){c0[0], c0[1], c0[2], c0[3], c1[0], c1[1], c1[2], c1[3]};
                const bf16x8 pf = __builtin_bit_cast(bf16x8, pw[ks]);
                o0 = __builtin_amdgcn_mfma_f32_32x32x16_bf16(v0, pf, o0, 0, 0, 0);
                o1 = __builtin_amdgcn_mfma_f32_32x32x16_bf16(v1, pf, o1, 0, 0, 0); }
        }
        if (has_next) { *(LAS v4u*)(lds + L_K + ((s + 1) & 1) * 8192 + stoff) = kreg; *(LAS v4u*)(lds + L_V + ((s + 1) & 1) * 8192 + stoff) = vreg; }
        __syncthreads();
    }
#undef MOBA_TILE_ROW
    const float inv = 1.0f / l;
    const size_t row = rowbase + q0 + wid * 32 + r32;
    const bf16_t* zp = U1 + row * 4096 + 3072 + h * 64; bf16_t* op = (bf16_t*)(P.ws + WS_YG + 32 * MiB) + row * 1024 + h * 64;
#pragma unroll
    for (int g = 0; g < 4; ++g) {
        const int d = 8 * g + 4 * hi;
        const v2u z0 = *(const v2u*)(zp + d), z1 = *(const v2u*)(zp + 32 + d);
        v2u w0, w1;
        w0.x = cvtpk(o0[4 * g] * inv * bf2f(z0.x & 0xffffu), o0[4 * g + 1] * inv * bf2f(z0.x >> 16)); w0.y = cvtpk(o0[4 * g + 2] * inv * bf2f(z0.y & 0xffffu), o0[4 * g + 3] * inv * bf2f(z0.y >> 16));
        w1.x = cvtpk(o1[4 * g] * inv * bf2f(z1.x & 0xffffu), o1[4 * g + 1] * inv * bf2f(z1.x >> 16)); w1.y = cvtpk(o1[4 * g + 2] * inv * bf2f(z1.y & 0xffffu), o1[4 * g + 3] * inv * bf2f(z1.y >> 16));
        *(v2u*)(op + d) = w0; *(v2u*)(op + 32 + d) = w1;
    }
    __syncthreads();
}
__device__ __forceinline__ void phase(const Params& P, LAS unsigned char* lds, int G, int bx) {
    if (G == 256) {
        const int vcu = (bx % 8) * (G / 8) + bx / 8, bh = vcu >> 1, odd = vcu & 1;
        for (int i = 0; i < 4; ++i) { const int nb = odd ? ((i == 0) ? 6 : (i == 1) ? 1 : (i == 2) ? 4 : 3) : ((i == 0) ? 7 : (i == 1) ? 0 : (i == 2) ? 5 : 2);
            unit(P, bh >> 4, bh & 15, nb, lds); }
    } else {
        for (int u = bx; u < BATCH * 16 * 8; u += G) unit(P, u / 128, (u / 8) % 16, u % 8, lds);
    }
}
}
constexpr int RING_BYTES = 131072, LDSCTL_OFF = RING_BYTES, MISC_OFF = LDSCTL_OFF + 320, LDS_BYTES = 147456;
__global__ void __launch_bounds__(512, 2) mk_fwd(Params P) {
    extern __shared__ __attribute__((aligned(16))) unsigned char lds_raw[];
    LAS unsigned char* lds = (LAS unsigned char*)lds_raw;
    const int tid = threadIdx.x, lane = tid & 63, wave = __builtin_amdgcn_readfirstlane(tid >> 6);
    const int G = gridDim.x, gw = blockIdx.x * 8 + wave, NGW = G * 8;
    volatile LAS unsigned* MISC = (volatile LAS unsigned*)(lds + MISC_OFF);
    for (int u = tid; u < (LDS_BYTES - LDSCTL_OFF) / 4; u += 512) ((LAS unsigned*)(lds + LDSCTL_OFF))[u] = 0u;
    __syncthreads();
    unsigned char* ws = P.ws;
    XcdBarrier bar = xcd_barrier_post((unsigned*)(ws + WS_CTL + CTL_BAR), MISC + 8);

    p0_phase(P, lds, gw, NGW, lane, wave);
    xcd_barrier(bar);
    { pg8::Gemm g{(const bf16_t*)P.out, (const bf16_t*)(ws + WS_BT0), MTOK, N0, 1024, 0}; pg8::EpiU0 E{(bf16_t*)(ws + WS_U), (float*)(ws + WS_SM), -1, 0};
      pg8::StaticOrder S; S.init(MTOK, N0, G, (int)blockIdx.x);
#ifndef NO_G1
      pg8::gemm_phase<pg8::EpiU0, pg8::StaticOrder, true, true>(lds, g, S, E);
#endif
      }
    xcd_barrier(bar);
    if (wave == 0) {
        const int unit = blockIdx.x;
#ifndef NO_SSD
        if (unit < 128) ssd_naive_wave(P, unit / 16, unit % 16, lane, (LAS float*)lds, (LAS float*)lds + 64);
#endif
#ifndef NO_GLA
        if (unit >= 128 && unit < 192) gla_naive_wave(P, (unit - 128) / 8, (unit - 128) % 8, lane, (LAS float*)lds, (LAS float*)lds + 64, (LAS float*)lds + 128);
#endif
    }
    xcd_barrier(bar);
    { pg8::Gemm g{(const bf16_t*)(ws + WS_YG), (const bf16_t*)(ws + WS_BT1), MTOK, 1024, 2048, 0}; pg8::EpiRes<true> E{P.x, P.out, (const float*)(ws + WS_CTL + CTL_SSQ), 16, 0};
      pg8::StaticOrder S; S.init(MTOK, 1024, G, (int)blockIdx.x);
#ifndef NO_G2
      pg8::gemm_phase<pg8::EpiRes<true>, pg8::StaticOrder, true, true>(lds, g, S, E);
#endif
      }
    xcd_barrier(bar);
    p3b_phase(P, lds, gw, NGW, lane, wave);
    xcd_barrier(bar);
    { pg8::Gemm g{(const bf16_t*)(ws + WS_YG), (const bf16_t*)(ws + WS_BT2), MTOK, N1, 1024, 0}; pg8::EpiU1 E{(bf16_t*)(ws + WS_U), (float*)(ws + WS_CTL + CTL_KSUM), QK_C2, -1};
      pg8::StaticOrder S; S.init(MTOK, N1, G, (int)blockIdx.x);
#ifndef NO_G3
      pg8::gemm_phase<pg8::EpiU1, pg8::StaticOrder, true, true>(lds, g, S, E);
#endif
      }
    xcd_barrier(bar);
#ifdef MOBA_NAIVE
    for (int it = 0; it < (BATCH * 16 * 8) / (2 * G) + (((BATCH * 16 * 8) % (2 * G)) ? 1 : 0); ++it) {
        const int unit = (it * G + (int)blockIdx.x) * 2 + (tid >> 8);
        const bool live = unit < BATCH * 16 * 8;
        const int b = unit / 128, h = (unit / 8) % 16, nb = unit % 8;
        LAS float* skm = (LAS float*)lds + (tid >> 8) * 512;
        const float* ksum = (const float*)(ws + WS_CTL + CTL_KSUM);
        __syncthreads();
        if (live) for (int i = tid & 255; i < 512; i += 256) skm[i] = ksum[(size_t)(b * 8 + (i >> 6)) * 1024 + h * 64 + (i & 63)];
        __syncthreads();
#ifndef NO_MOBA
        if (live) moba_naive_row(P, b, h, nb, tid & 255, skm);
#endif
    }
#else
    moba::phase(P, lds, G, (int)blockIdx.x);
#endif
    xcd_barrier(bar);
    { pg8::Gemm g{(const bf16_t*)(ws + WS_YG + 32 * MiB), (const bf16_t*)(ws + WS_BT3), MTOK, 1024, 1024, 0}; pg8::EpiRes<false> E{P.out, P.out, nullptr, -1, 0};
      pg8::StaticOrder S; S.init(MTOK, 1024, G, (int)blockIdx.x);
#ifndef NO_G4
      pg8::gemm_phase<pg8::EpiRes<false>, pg8::StaticOrder, true, true>(lds, g, S, E);
#endif
      }
    xcd_barrier(bar);
    for (int m = gw; m < MTOK; m += NGW) rms_row_f32(P.out + (size_t)m * 1024, P.final_norm, P.out + (size_t)m * 1024, lane);
}

extern "C" void kernel_launch(void* const* d_in, const int* in_sizes, int n_in, void* d_out, int out_size, void* d_ws, size_t ws_size, hipStream_t stream) {
    static int grid = 0;
    if (grid == 0) {
        if (n_in != 17 || in_sizes[0] != MTOK * DM || out_size != MTOK * DM || ws_size < WS_END) { fprintf(stderr, "kernel_launch: unexpected shapes (n_in %d, in0 %d, out %d, ws %zu)\n", n_in, n_in > 0 ? in_sizes[0] : -1, out_size, ws_size); grid = -1; return; }
        int dev = 0, cus = 0, per_cu = 0;
        if (hipGetDevice(&dev) != hipSuccess || hipDeviceGetAttribute(&cus, hipDeviceAttributeMultiprocessorCount, dev) != hipSuccess) { grid = -1; return; }
        if (hipFuncSetAttribute((const void*)mk_fwd, hipFuncAttributeMaxDynamicSharedMemorySize, LDS_BYTES) != hipSuccess) { fprintf(stderr, "kernel_launch: hipFuncSetAttribute failed\n"); grid = -1; return; }
        if (hipOccupancyMaxActiveBlocksPerMultiprocessor(&per_cu, (const void*)mk_fwd, 512, LDS_BYTES) != hipSuccess || per_cu < 1) { fprintf(stderr, "kernel_launch: occupancy query says %d blocks per CU\n", per_cu); }
        (void)hipGetLastError();
        grid = cus;
    }
    if (grid < 0) return;
    if (hipMemsetAsync((char*)d_ws + WS_CTL, 0, CTL_BYTES, stream) != hipSuccess) return;
    Params P{};
    const float** pp = (const float**)&P;
    for (int i = 0; i < 17; ++i) pp[i] = (const float*)d_in[i];
    P.out = (float*)d_out; P.ws = (unsigned char*)d_ws;
    hipLaunchKernelGGL(mk_fwd, dim3(grid), dim3(512), LDS_BYTES, stream, P);
}
```

```cpp
#include <hip/hip_runtime.h>
#include <cstdio>
#include <cstdint>

constexpr int BATCH = 8, SEQ = 2048, DM = 1024, MTOK = BATCH * SEQ;
constexpr int N0 = 5632, U0P = 5376;
constexpr int COL_Z = 0, COL_XBC = 1024, COL_Q = 2304, COL_K = 2816, COL_V = 3328, COL_G = 4352;
constexpr int N1 = 4096;
constexpr float RMS_EPS = 1e-6f;
constexpr float QK_C2 = 0.125f * 1.4426950408889634f;
constexpr size_t MiB = 1u << 20;
constexpr size_t WS_CTL = 0, CTL_BYTES = 2 * MiB;
constexpr size_t WS_BT0 = 2 * MiB;
constexpr size_t WS_BT2 = 2 * MiB, WS_BT3 = 10 * MiB;
constexpr size_t WS_BT1 = 13 * MiB;
constexpr size_t WS_SM = 17 * MiB;
constexpr size_t WS_U = 19 * MiB;
constexpr size_t WS_YG = 187 * MiB;
constexpr size_t WS_END = 251 * MiB;
constexpr size_t CTL_SSQ = 64 * 1024;
constexpr size_t CTL_KSUM = 256 * 1024;
constexpr size_t CTL_BAR = 1024 * 1024;

#define LAS __attribute__((address_space(3)))
typedef unsigned short bf16_t;
typedef unsigned v4u __attribute__((ext_vector_type(4)));
typedef unsigned v2u __attribute__((ext_vector_type(2)));
typedef float v4f __attribute__((ext_vector_type(4)));

__device__ __forceinline__ unsigned f2bf(float f) { unsigned u = __builtin_bit_cast(unsigned, f); return (u + 0x7fffu + ((u >> 16) & 1u)) >> 16; }
__device__ __forceinline__ unsigned pk2(float lo, float hi) { return f2bf(lo) | (f2bf(hi) << 16); }
__device__ __forceinline__ float bf2f(unsigned h) { return __builtin_bit_cast(float, h << 16); }
__device__ __forceinline__ float silu_f(float x) { return x / (1.f + __expf(-x)); }
__device__ __forceinline__ float softplus_f(float x) { return x > 20.f ? x : log1pf(__expf(x)); }
__device__ __forceinline__ float logsigmoid_f(float x) { return fminf(x, 0.f) - log1pf(__expf(-fabsf(x))); }
__device__ __forceinline__ float wave_sum(float v) {
#pragma unroll
    for (int o = 1; o < 64; o <<= 1) v += __shfl_xor(v, o);
    return v;
}
namespace pg8 {
#define PG8_LAS __attribute__((address_space(3)))
typedef unsigned short bf16_t;
typedef short bf16x8 __attribute__((ext_vector_type(8)));
typedef float f32x4 __attribute__((ext_vector_type(4)));
typedef unsigned u32x4 __attribute__((ext_vector_type(4)));
constexpr int BM = 256, BK = 64, HALF = 128, HTB = HALF * BK * 2  , STAGE_BYTES = 8 * HTB, NXCD = 8, WGM = 8;

__host__ __device__ __forceinline__ int lds_byte(int r, int c) { const int st = (r >> 4) * 2 + (c >> 5), rr = r & 15, cc = c & 31, ob = rr * 64 + cc * 2; return st * 1024 + (ob ^ (((ob >> 9) & 1) << 5)); }
__host__ __device__ __forceinline__ void stage_rc(int b, int& R, int& C) { const int st = b / 1024, sb = b % 1024, swz = sb ^ (((sb >> 9) & 1) << 5); R = (st >> 1) * 16 + swz / 64; C = (st & 1) * 32 + (swz % 64) / 2; }
__host__ __device__ __forceinline__ int perm32(int rho) { const int n = rho >> 4, i = rho & 15; return 8 * (i >> 2) + 4 * n + (i & 3); }

struct Unit { int pm, pn; };
struct Gemm { const bf16_t* A; const bf16_t* Bt; int M, N, K, pad; };

struct StaticOrder {
    int nM, nN, nwg, G, c;
    __host__ __device__ void init(int M, int N, int G_, int c_) { nM = M / BM; nN = N / BM; nwg = nM * nN; G = G_; c = c_; }
    __host__ __device__ bool next(int i, Unit& u) const {
        const long L = (long)i * G + c; if (L >= nwg) return false;
        int wgid = (int)L; { const int q = nwg / NXCD, r = nwg % NXCD, xcd = wgid % NXCD, off = wgid / NXCD; wgid = (xcd < r ? xcd * (q + 1) : r * (q + 1) + (xcd - r) * q) + off; }
        const int nig = WGM * nN, gid = wgid / nig, fm = gid * WGM, gsz = (nM - fm) < WGM ? (nM - fm) : WGM;
        u.pm = fm + ((wgid % nig) % gsz); u.pn = (wgid % nig) / gsz; return true;
    }
    __device__ __forceinline__ void a_ready(const Unit&) const {}
    __device__ __forceinline__ void done(const Unit&) const {}
};

__device__ __forceinline__ unsigned cvt_pk_bf16(float lo, float hi) { unsigned r; asm volatile("v_cvt_pk_bf16_f32 %0, %1, %2" : "=v"(r) : "v"(lo), "v"(hi)); return r; }

struct EpiU0 {
    static constexpr bool PERM = true, AFTER_DRAIN = false, MIDK = false;
    bf16_t* U; float* SM; int midk_t, pad;
    __device__ __forceinline__ void midk(f32x4 (&)[2][2][4][2], const Unit&, int, int) const {}
    __device__ __forceinline__ void operator()(const f32x4 (&acc)[2][2][4][2], const Unit& u, int wr, int wc, int fr, int fq) const {
        const int row0 = u.pm * BM + wr * 64 + fr;
        if (u.pn < 21) {
            const int col0 = u.pn * BM + wc * 32 + 8 * fq;
#pragma unroll
            for (int ai = 0; ai < 2; ++ai)
#pragma unroll
                for (int m = 0; m < 4; ++m) { bf16_t* rowp = U + (size_t)(row0 + ai * HALF + m * 16) * 5376 + col0;
#pragma unroll
                    for (int bj = 0; bj < 2; ++bj) { const f32x4 v0 = acc[ai][bj][m][0], v1 = acc[ai][bj][m][1];
                        u32x4 w; w.x = cvt_pk_bf16(v0[0], v0[1]); w.y = cvt_pk_bf16(v0[2], v0[3]); w.z = cvt_pk_bf16(v1[0], v1[1]); w.w = cvt_pk_bf16(v1[2], v1[3]);
                        *(u32x4*)(rowp + bj * HALF) = w; } }
        } else if (wc == 0) {
#pragma unroll
            for (int ai = 0; ai < 2; ++ai)
#pragma unroll
                for (int m = 0; m < 4; ++m) { float* rp = SM + (size_t)(row0 + ai * HALF + m * 16) * 32 + 8 * fq;
                    *(f32x4*)rp = acc[ai][0][m][0]; *(f32x4*)(rp + 4) = acc[ai][0][m][1]; }
        }
    }
};
template <bool SCALE> struct EpiRes {
    static constexpr bool PERM = false, AFTER_DRAIN = false, MIDK = SCALE;
    const float* base; float* out; const float* ssq; int midk_t, pad;
    __device__ __forceinline__ void midk(f32x4 (&acc)[2][2][4][2], const Unit& u, int wr, int fr) const {
#pragma unroll
        for (int ai = 0; ai < 2; ++ai)
#pragma unroll
            for (int m = 0; m < 4; ++m) { const float s = __builtin_amdgcn_rsqf(ssq[u.pm * BM + ai * HALF + wr * 64 + m * 16 + fr] * (1.0f / 1024.0f) + 1e-6f);
#pragma unroll
                for (int bj = 0; bj < 2; ++bj)
#pragma unroll
                    for (int n = 0; n < 2; ++n) acc[ai][bj][m][n] *= s;
                asm volatile("" ::: "memory"); }
    }
    __device__ __forceinline__ void operator()(const f32x4 (&acc)[2][2][4][2], const Unit& u, int wr, int wc, int fr, int fq) const {
        const int col0 = u.pn * BM + wc * 32 + 4 * fq;
#pragma unroll
        for (int ai = 0; ai < 2; ++ai)
#pragma unroll
            for (int m = 0; m < 4; ++m) { const size_t off = (size_t)(u.pm * BM + ai * HALF + wr * 64 + m * 16 + fr) * 1024 + col0;
#pragma unroll
                for (int bj = 0; bj < 2; ++bj)
#pragma unroll
                    for (int n = 0; n < 2; ++n) { const f32x4 b = *(const f32x4*)(base + off + bj * HALF + n * 16); *(f32x4*)(out + off + bj * HALF + n * 16) = b + acc[ai][bj][m][n]; } }
    }
};
struct EpiU1 {
    static constexpr bool PERM = true, AFTER_DRAIN = false, MIDK = false;
    bf16_t* U; float* ksum; float qscale; int midk_t;
    __device__ __forceinline__ void midk(f32x4 (&)[2][2][4][2], const Unit&, int, int) const {}
    __device__ __forceinline__ void operator()(const f32x4 (&acc)[2][2][4][2], const Unit& u, int wr, int wc, int fr, int fq) const {
        const int row0 = u.pm * BM + wr * 64 + fr, col0 = u.pn * BM + wc * 32 + 8 * fq;
        const int kind = u.pn >> 2;
        const float sc = (kind == 0) ? qscale : 1.f;
#pragma unroll
        for (int ai = 0; ai < 2; ++ai)
#pragma unroll
            for (int m = 0; m < 4; ++m) { bf16_t* rowp = U + (size_t)(row0 + ai * HALF + m * 16) * 4096 + col0;
#pragma unroll
                for (int bj = 0; bj < 2; ++bj) { f32x4 v0 = acc[ai][bj][m][0] * sc, v1 = acc[ai][bj][m][1] * sc;
                    if (kind == 3) {
#pragma unroll
                        for (int i = 0; i < 4; ++i) { v0[i] = v0[i] * __builtin_amdgcn_rcpf(1.f + __builtin_amdgcn_exp2f(-1.4426950408889634f * v0[i])); v1[i] = v1[i] * __builtin_amdgcn_rcpf(1.f + __builtin_amdgcn_exp2f(-1.4426950408889634f * v1[i])); } }
                    u32x4 w; w.x = cvt_pk_bf16(v0[0], v0[1]); w.y = cvt_pk_bf16(v0[2], v0[3]); w.z = cvt_pk_bf16(v1[0], v1[1]); w.w = cvt_pk_bf16(v1[2], v1[3]);
                    *(u32x4*)(rowp + bj * HALF) = w; } }
        if (kind == 1) {
            float* kp = ksum + (size_t)u.pm * 1024 + (col0 - 1024);
#pragma unroll
            for (int bj = 0; bj < 2; ++bj)
#pragma unroll
                for (int n = 0; n < 2; ++n) { f32x4 s = (f32x4){0.f, 0.f, 0.f, 0.f};
#pragma unroll
                    for (int ai = 0; ai < 2; ++ai)
#pragma unroll
                        for (int m = 0; m < 4; ++m) s += acc[ai][bj][m][n];
#pragma unroll
                    for (int i = 0; i < 4; ++i) { float t = s[i]; t += __shfl_xor(t, 1); t += __shfl_xor(t, 2); t += __shfl_xor(t, 4); t += __shfl_xor(t, 8); s[i] = t; }
                    if (fr == 0) {
#pragma unroll
                        for (int i = 0; i < 4; ++i) atomicAdd(kp + bj * HALF + 4 * n + i, s[i]); } }
        }
    }
};
template <class Epi, class Sched, bool ALIGN_EPI = false, bool SP2 = false>
__device__ __forceinline__ void gemm_phase(PG8_LAS unsigned char* lds, const Gemm g, const Sched& S, const Epi& E) {
    int tid_ = threadIdx.x; asm volatile("" : "+v"(tid_));
    const int tid = tid_, wid = __builtin_amdgcn_readfirstlane(tid >> 6), lane = tid & 63, wr = wid >> 2, wc = wid & 3, fr = lane & 15, fq = lane >> 4;
    const int K = g.K, nt = K / BK;
    unsigned voffA[2], voffB[2];
#pragma unroll
    for (int i = 0; i < 2; ++i) { int R, C; stage_rc(tid * 16 + i * 8192, R, C); const int Rb = Epi::PERM ? ((R & ~31) + perm32(R & 31)) : R;
        voffA[i] = (unsigned)(R * K + C) * 2u; voffB[i] = (unsigned)(Rb * K + C) * 2u; }
    const size_t kstep = (size_t)(BK * 2);
    const size_t hstep = (size_t)HALF * K * 2;
    const size_t tstep = 2 * hstep;
    const unsigned ldsw = (unsigned)wid * 1024u;
    const int aoff = lds_byte(wr * 64 + fr, fq * 8), boff = lds_byte(wc * 32 + fr, fq * 8);
#define PG8_SA(b, h) (((b) * 2 + (h)) * HTB)
#define PG8_SB(b, h) ((4 + (b) * 2 + (h)) * HTB)
#define PG8_STAGE(bufoff, gbase, voff) do { _Pragma("unroll") for (int _i = 0; _i < 2; ++_i) \
        __builtin_amdgcn_global_load_lds((const unsigned*)((const char*)(gbase) + (voff)[_i]), (PG8_LAS unsigned*)(lds + (bufoff) + ldsw + _i * 8192), 16, 0, 0); } while (0)
#define PG8_LDA(dst, b, h) do { _Pragma("unroll") for (int m = 0; m < 4; ++m) _Pragma("unroll") for (int k = 0; k < 2; ++k) dst[m][k] = *(const PG8_LAS bf16x8*)(lds + PG8_SA(b, h) + aoff + m * 2048 + k * 1024); } while (0)
#define PG8_LDB(dst, b, h) do { _Pragma("unroll") for (int n = 0; n < 2; ++n) _Pragma("unroll") for (int k = 0; k < 2; ++k) dst[n][k] = *(const PG8_LAS bf16x8*)(lds + PG8_SB(b, h) + boff + n * 2048 + k * 1024); } while (0)
#define PG8_MMA(ai, bj, At, Bt) do { __builtin_amdgcn_s_setprio(1); _Pragma("unroll") for (int m = 0; m < 4; ++m) _Pragma("unroll") for (int n = 0; n < 2; ++n) _Pragma("unroll") for (int k = 0; k < 2; ++k) \
        acc[ai][bj][m][n] = __builtin_amdgcn_mfma_f32_16x16x32_bf16(Bt[n][k], At[m][k], acc[ai][bj][m][n], 0, 0, 0); __builtin_amdgcn_s_setprio(0); } while (0)
#define PG8_WAIT_V(n) asm volatile("s_waitcnt vmcnt(" #n ")" ::: "memory")
#define PG8_WAIT_L(n) asm volatile("s_waitcnt lgkmcnt(" #n ")" ::: "memory")
#define PG8_BAR __builtin_amdgcn_s_barrier()
#define PG8_SCHED __builtin_amdgcn_sched_barrier(0)
    Unit cur, nxt; int ui = 0;
    if (!S.next(0, cur)) return;
    f32x4 acc[2][2][4][2];
#pragma unroll
    for (int a = 0; a < 2; ++a)
#pragma unroll
        for (int b = 0; b < 2; ++b)
#pragma unroll
            for (int m = 0; m < 4; ++m)
#pragma unroll
                for (int n = 0; n < 2; ++n) acc[a][b][m][n] = (f32x4){0.f, 0.f, 0.f, 0.f};
    bf16x8 At[4][2], B0[2][2], B1[2][2];
    const char* cA = (const char*)g.A + (size_t)cur.pm * tstep; const char* cB = (const char*)g.Bt + (size_t)cur.pn * tstep;
    S.a_ready(cur);
    if constexpr (SP2) {
        PG8_STAGE(PG8_SB(0, 0), cB, voffB); PG8_STAGE(PG8_SB(0, 1), cB + hstep, voffB); PG8_STAGE(PG8_SA(0, 0), cA, voffA); PG8_STAGE(PG8_SA(0, 1), cA + hstep, voffA);
        if (wr == 1) PG8_BAR;
        PG8_WAIT_V(2); PG8_BAR;
        PG8_STAGE(PG8_SB(1, 0), cB + kstep, voffB); PG8_STAGE(PG8_SA(1, 0), cA + kstep, voffA); PG8_STAGE(PG8_SB(1, 1), cB + hstep + kstep, voffB);
        PG8_WAIT_V(6); PG8_BAR;
    } else {
        PG8_STAGE(PG8_SB(0, 0), cB, voffB); PG8_STAGE(PG8_SA(0, 0), cA, voffA); PG8_STAGE(PG8_SB(0, 1), cB + hstep, voffB); PG8_STAGE(PG8_SA(0, 1), cA + hstep, voffA);
        if (wr == 1) PG8_BAR;
        PG8_WAIT_V(4); PG8_BAR;
        PG8_STAGE(PG8_SB(1, 0), cB + kstep, voffB); PG8_STAGE(PG8_SA(1, 0), cA + kstep, voffA); PG8_STAGE(PG8_SB(1, 1), cB + hstep + kstep, voffB);
        PG8_WAIT_V(6); PG8_BAR;
    }
    for (;;) {
        const bool has_next = S.next(ui + 1, nxt);
        const char* nA = has_next ? (const char*)g.A + (size_t)nxt.pm * tstep : cA; const char* nB = has_next ? (const char*)g.Bt + (size_t)nxt.pn * tstep : cB;
        for (int t = 0; t < nt; t += 2) {
            if constexpr (Epi::MIDK) { if (t == E.midk_t) E.midk(acc, cur, wr, fr); }
            const bool last = (t == nt - 2);
            const char* a1 = cA + (size_t)(t + 1) * kstep;
            const char* a2 = last ? nA : cA + (size_t)(t + 2) * kstep; const char* b2 = last ? nB : cB + (size_t)(t + 2) * kstep;
            const char* a3 = a2 + kstep; const char* b3 = b2 + kstep;
            if (last && has_next) S.a_ready(nxt);
            if constexpr (SP2) {
            PG8_LDB(B0, 0, 0); PG8_LDB(B1, 0, 1); PG8_SCHED; PG8_LDA(At, 0, 0); PG8_STAGE(PG8_SA(1, 1), a1 + hstep, voffA);
            PG8_WAIT_V(8); PG8_WAIT_L(0); PG8_BAR; PG8_MMA(0, 0, At, B0); PG8_MMA(0, 1, At, B1); PG8_BAR; PG8_SCHED;
            PG8_LDA(At, 0, 1); PG8_STAGE(PG8_SB(0, 0), b2, voffB); PG8_STAGE(PG8_SB(0, 1), b2 + hstep, voffB); PG8_STAGE(PG8_SA(0, 0), a2, voffA);
            PG8_WAIT_V(8); PG8_WAIT_L(0); PG8_BAR; PG8_MMA(1, 0, At, B0); PG8_MMA(1, 1, At, B1); PG8_BAR; PG8_SCHED;
            PG8_LDB(B0, 1, 0); PG8_LDB(B1, 1, 1); PG8_SCHED; PG8_LDA(At, 1, 0); PG8_STAGE(PG8_SA(0, 1), a2 + hstep, voffA);
            PG8_WAIT_V(8); PG8_WAIT_L(0); PG8_BAR; PG8_MMA(0, 0, At, B0); PG8_MMA(0, 1, At, B1); PG8_BAR; PG8_SCHED;
            PG8_LDA(At, 1, 1); PG8_STAGE(PG8_SB(1, 0), b3, voffB); PG8_STAGE(PG8_SB(1, 1), b3 + hstep, voffB); PG8_STAGE(PG8_SA(1, 0), a3, voffA);
            PG8_WAIT_V(8); PG8_WAIT_L(0); PG8_BAR; PG8_MMA(1, 0, At, B0); PG8_MMA(1, 1, At, B1); PG8_BAR; PG8_SCHED;
            } else {
            PG8_LDB(B0, 0, 0); PG8_SCHED; PG8_LDA(At, 0, 0); PG8_STAGE(PG8_SA(1, 1), a1 + hstep, voffA);
            PG8_WAIT_L(8); PG8_BAR; PG8_WAIT_L(0); PG8_MMA(0, 0, At, B0); PG8_BAR; PG8_SCHED;
            PG8_LDB(B1, 0, 1); PG8_STAGE(PG8_SB(0, 0), b2, voffB);
            PG8_BAR; PG8_WAIT_L(0); PG8_MMA(0, 1, At, B1); PG8_BAR;
            PG8_LDA(At, 0, 1); PG8_STAGE(PG8_SA(0, 0), a2, voffA);
            PG8_BAR; PG8_WAIT_L(0); PG8_MMA(1, 0, At, B0); PG8_BAR; PG8_SCHED;
            PG8_STAGE(PG8_SB(0, 1), b2 + hstep, voffB);
            PG8_WAIT_V(6); PG8_BAR; PG8_MMA(1, 1, At, B1); PG8_BAR;
            PG8_LDB(B0, 1, 0); PG8_SCHED; PG8_LDA(At, 1, 0); PG8_STAGE(PG8_SA(0, 1), a2 + hstep, voffA);
            PG8_WAIT_L(8); PG8_BAR; PG8_WAIT_L(0); PG8_MMA(0, 0, At, B0); PG8_BAR; PG8_SCHED;
            PG8_LDB(B1, 1, 1); PG8_STAGE(PG8_SB(1, 0), b3, voffB);
            PG8_BAR; PG8_WAIT_L(0); PG8_MMA(0, 1, At, B1); PG8_BAR;
            PG8_LDA(At, 1, 1); PG8_STAGE(PG8_SA(1, 0), a3, voffA);
            PG8_BAR; PG8_WAIT_L(0); PG8_MMA(1, 0, At, B0); PG8_BAR; PG8_SCHED;
            PG8_STAGE(PG8_SB(1, 1), b3 + hstep, voffB);
            PG8_WAIT_V(6); PG8_BAR; PG8_MMA(1, 1, At, B1); PG8_BAR;
            }
        }
        if constexpr (ALIGN_EPI) { if (wr == 0) PG8_BAR; }
        if constexpr (!Epi::AFTER_DRAIN) { E(acc, cur, wr, wc, fr, fq); S.done(cur); }
        if (!has_next) break;
#pragma unroll
        for (int a = 0; a < 2; ++a)
#pragma unroll
            for (int b = 0; b < 2; ++b)
#pragma unroll
                for (int m = 0; m < 4; ++m)
#pragma unroll
                    for (int n = 0; n < 2; ++n) acc[a][b][m][n] = (f32x4){0.f, 0.f, 0.f, 0.f};
        cur = nxt; cA = nA; cB = nB; ++ui;
        if constexpr (ALIGN_EPI) { if (wr == 1) PG8_BAR; }
    }
    PG8_WAIT_V(0);
    if constexpr (!ALIGN_EPI) { if (wr == 0) PG8_BAR; }
    PG8_BAR;
    if constexpr (Epi::AFTER_DRAIN) { E.fused(acc, cur, wr, wc, fr, fq, lds, wid, lane); S.done(cur); }
#undef PG8_SA
#undef PG8_SB
#undef PG8_STAGE
#undef PG8_LDA
#undef PG8_LDB
#undef PG8_MMA
#undef PG8_WAIT_V
#undef PG8_WAIT_L
#undef PG8_BAR
#undef PG8_SCHED
}
}
#define XB_TMO      128
#define XB_XCNT(j)  (256  + 64 * (j))
#define XB_XSUB(j)  (1280 + 64 * (j))
#define XB_XGEN(j)  (2304 + 64 * (j))
#define XB_TOP      3328
#define XB_TOPGEN   3392
#define XCD_BAR_WORDS 3456
#define XB_SPIN_CAP (1u << 18)

__device__ __forceinline__ unsigned xb_ld(unsigned* p)              { return __hip_atomic_load(p, __ATOMIC_RELAXED, __HIP_MEMORY_SCOPE_AGENT); }
__device__ __forceinline__ unsigned xb_add(unsigned* p, unsigned v) { return __hip_atomic_fetch_add(p, v, __ATOMIC_RELAXED, __HIP_MEMORY_SCOPE_AGENT); }
__device__ __forceinline__ unsigned xb_xcc_id() { return (unsigned)__builtin_amdgcn_s_getreg((3 << 11) | 20) & 0xFu; }
#define XB_SPIN(cond, bar) do { unsigned _sp = 0; while (cond) { __builtin_amdgcn_s_sleep(1); \
    if ((++_sp & 255u) == 0u) { if (xb_ld(&(bar)[XB_TMO])) break; if (_sp > XB_SPIN_CAP) { atomicAdd(&(bar)[XB_TMO], 1u); break; } } } } while (0)

struct XcdBarrier {
    unsigned* bar; unsigned x;
    volatile LAS unsigned* st;
};

__device__ __forceinline__ XcdBarrier xcd_barrier_post(unsigned* bar, volatile LAS unsigned* st) {
    XcdBarrier b; b.bar = bar; b.x = xb_xcc_id(); b.st = st;
    if (threadIdx.x == 0) (void)xb_add(&bar[XB_XCNT(b.x)], 1u);
    return b;
}
__device__ __forceinline__ void xcd_barrier_complete(unsigned* bar, unsigned x, unsigned& nloc, unsigned& nx) {
    const unsigned G = gridDim.x * gridDim.y * gridDim.z;
    unsigned sum, cnt, mine, sp = 0u;
    for (;;) {
        sum = 0u; cnt = 0u; mine = 0u;
#pragma unroll
        for (unsigned j = 0; j < 16; ++j) { const unsigned c = xb_ld(&bar[XB_XCNT(j)]); sum += c; cnt += (c > 0u) ? 1u : 0u; mine = (j == x) ? c : mine; }
        if (sum == G) break;
        __builtin_amdgcn_s_sleep(1);
        if ((++sp & 255u) == 0u) { if (xb_ld(&bar[XB_TMO])) break; if (sp > XB_SPIN_CAP) { atomicAdd(&bar[XB_TMO], 1u); break; } }
    }
    nloc = mine > 0u ? mine : 1u; nx = cnt > 0u ? cnt : 1u;
}

__device__ __forceinline__ void xcd_barrier(const XcdBarrier& b) {
    asm volatile("s_waitcnt vmcnt(0)" ::: "memory");
    __syncthreads();
    if (threadIdx.x == 0) {
        unsigned* bar = b.bar;
        __builtin_amdgcn_s_waitcnt(0);
        unsigned nloc = b.st[0], nx = b.st[1];
        if (nloc == 0u) { xcd_barrier_complete(bar, b.x, nloc, nx); b.st[0] = nloc; b.st[1] = nx; }
        const unsigned old = xb_add(&bar[XB_XSUB(b.x)], 1u);
        const unsigned gen = old / nloc;
        if (old + 1u == (gen + 1u) * nloc) {
            __builtin_amdgcn_fence(__ATOMIC_RELEASE, "agent");
            asm volatile("s_waitcnt vmcnt(0)" ::: "memory");
            const unsigned og = xb_add(&bar[XB_TOP], 1u);
            const unsigned tg = og / nx;
            if (og + 1u == (tg + 1u) * nx) xb_add(&bar[XB_TOPGEN], 1u);
            else XB_SPIN(xb_ld(&bar[XB_TOPGEN]) == tg, bar);
            __builtin_amdgcn_fence(__ATOMIC_ACQUIRE, "agent");
            xb_add(&bar[XB_XGEN(b.x)], 1u);
            asm volatile("s_waitcnt vmcnt(0)" ::: "memory");
        } else {
            XB_SPIN(xb_ld(&bar[XB_XGEN(b.x)]) == gen, bar);
            __builtin_amdgcn_fence(__ATOMIC_ACQUIRE, "agent");
            asm volatile("s_waitcnt vmcnt(0)" ::: "memory");
        }
    }
    __syncthreads();
}
template <int MAP> __device__ __forceinline__ int map_col(int n) {
    if (MAP == 0) return n;
    if (n < 2304) return n; if (n < 4352) return n + 16; if (n < 5376) return n + 32; if (n < 5392) return n - 5376 + 2304; if (n < 5408) return n - 5392 + 4368; return -1;
}
template <int MAP> __device__ __forceinline__ void transpose_item(const float* W, int K, int Nsrc, int Ndst, const float* kscale, int kscale_n, bf16_t* WT, LAS float* scr, int item, int lane) {
    const int nblk = Ndst / 32, kb = item / nblk, nb = item % nblk, k0 = 64 * kb, n0 = 32 * nb;
    const int sc = map_col<MAP>(n0 + (lane & 31));
#pragma unroll 8
    for (int i = 0; i < 32; ++i) { const int kk = 2 * i + (lane >> 5); float v = sc >= 0 ? W[(size_t)(k0 + kk) * Nsrc + sc] : 0.f; if (kscale && (k0 + kk) < kscale_n) v *= kscale[k0 + kk]; scr[kk * 33 + (lane & 31)] = v; }
    asm volatile("s_waitcnt lgkmcnt(0)" ::: "memory");
    const int c = lane & 7;
#pragma unroll
    for (int j = 0; j < 4; ++j) { const int n = (lane >> 3) + 8 * j; const LAS float* s = scr + (8 * c) * 33 + n;
        v4u o; o.x = pk2(s[0 * 33], s[1 * 33]); o.y = pk2(s[2 * 33], s[3 * 33]); o.z = pk2(s[4 * 33], s[5 * 33]); o.w = pk2(s[6 * 33], s[7 * 33]);
        *(v4u*)(WT + (size_t)(n0 + n) * K + k0 + 8 * c) = o; }
    asm volatile("s_waitcnt lgkmcnt(0)" ::: "memory");
}
__device__ __forceinline__ void rms_row_to_bf16(const float* xrow, const float* w, bf16_t* orow, int lane) {
    const v4f* xr = (const v4f*)xrow + lane; const v4f* wr = (const v4f*)w + lane;
    v4f v[4]; float s = 0.f;
#pragma unroll
    for (int j = 0; j < 4; ++j) { v[j] = xr[64 * j]; s += (v[j].x * v[j].x + v[j].y * v[j].y) + (v[j].z * v[j].z + v[j].w * v[j].w); }
    const float rstd = 1.0f / sqrtf(wave_sum(s) * (1.f / 1024.f) + RMS_EPS);
    unsigned long long* o8 = (unsigned long long*)orow + lane;
#pragma unroll
    for (int j = 0; j < 4; ++j) { const v4f ww = wr[64 * j]; o8[64 * j] = (unsigned long long)pk2(v[j].x * rstd * ww.x, v[j].y * rstd * ww.y) | ((unsigned long long)pk2(v[j].z * rstd * ww.z, v[j].w * rstd * ww.w) << 32); }
}
__device__ __forceinline__ void rms_row_f32(const float* xrow, const float* w, float* orow, int lane) {
    const v4f* xr = (const v4f*)xrow + lane; const v4f* wr = (const v4f*)w + lane;
    v4f v[4]; float s = 0.f;
#pragma unroll
    for (int j = 0; j < 4; ++j) { v[j] = xr[64 * j]; s += (v[j].x * v[j].x + v[j].y * v[j].y) + (v[j].z * v[j].z + v[j].w * v[j].w); }
    const float rstd = 1.0f / sqrtf(wave_sum(s) * (1.f / 1024.f) + RMS_EPS);
    v4f* o = (v4f*)orow + lane;
#pragma unroll
    for (int j = 0; j < 4; ++j) o[64 * j] = v[j] * rstd * wr[64 * j];
}

struct Params {
    const float *x, *even_norm, *even_w_in, *conv_w, *conv_b, *a_log, *dt_bias, *d_skip, *ssd_norm, *gate_w2, *gate_b, *gla_norm, *even_w_out, *odd_norm, *odd_w_in, *odd_w_out, *final_norm;
    float* out; unsigned char* ws;
};
#define WAVE_SYNC() do { asm volatile("s_waitcnt lgkmcnt(0)" ::: "memory"); __builtin_amdgcn_wave_barrier(); } while (0)

__device__ __forceinline__ void p0_phase(const Params& P, LAS unsigned char* lds, int gw, int NGW, int lane, int wave) {
    LAS float* scr = (LAS float*)lds + wave * 64 * 33;
    constexpr int I_A = (1024 / 64) * (N0 / 32), I_B = (2048 / 64) * (1024 / 32);
    for (int it = gw; it < I_A + I_B; it += NGW) {
        if (it < I_A) transpose_item<1>(P.even_w_in, 1024, 5408, N0, nullptr, 0, (bf16_t*)(P.ws + WS_BT0), scr, it, lane);
        else transpose_item<0>(P.even_w_out, 2048, 1024, 1024, P.ssd_norm, 1024, (bf16_t*)(P.ws + WS_BT1), scr, it - I_A, lane);
    }
    for (int m = gw; m < MTOK; m += NGW) rms_row_to_bf16(P.x + (size_t)m * 1024, P.even_norm, (bf16_t*)P.out + (size_t)m * 1024, lane);
}
__device__ __forceinline__ void p3b_phase(const Params& P, LAS unsigned char* lds, int gw, int NGW, int lane, int wave) {
    LAS float* scr = (LAS float*)lds + wave * 64 * 33;
    constexpr int I_A = (1024 / 64) * (4096 / 32), I_B = (1024 / 64) * (1024 / 32);
    for (int it = gw; it < I_A + I_B; it += NGW) {
        if (it < I_A) transpose_item<0>(P.odd_w_in, 1024, 4096, 4096, nullptr, 0, (bf16_t*)(P.ws + WS_BT2), scr, it, lane);
        else transpose_item<0>(P.odd_w_out, 1024, 1024, 1024, nullptr, 0, (bf16_t*)(P.ws + WS_BT3), scr, it - I_A, lane);
    }
    for (int m = gw; m < MTOK; m += NGW) rms_row_to_bf16(P.out + (size_t)m * 1024, P.odd_norm, (bf16_t*)(P.ws + WS_YG) + (size_t)m * 1024, lane);
}

__device__ __forceinline__ void ssd_naive_wave(const Params& P, int b, int hd, int p, LAS float* sB, LAS float* sC) {
    const bf16_t* U0 = (const bf16_t*)(P.ws + WS_U); const float* SM = (const float*)(P.ws + WS_SM);
    bf16_t* YG = (bf16_t*)(P.ws + WS_YG); float* ssq = (float*)(P.ws + WS_CTL + CTL_SSQ);
    const int g = hd / 8;
    const int cx = hd * 64 + p, cB = 1024 + g * 64 + p, cC = 1152 + g * 64 + p;
    float wx[4], wB[4], wC[4];
#pragma unroll
    for (int k = 0; k < 4; ++k) { wx[k] = P.conv_w[k * 1280 + cx]; wB[k] = P.conv_w[k * 1280 + cB]; wC[k] = P.conv_w[k * 1280 + cC]; }
    const float bx = P.conv_b[cx], bB = P.conv_b[cB], bC = P.conv_b[cC];
    const float a = -__expf(P.a_log[hd]), dtb = P.dt_bias[hd], Dk = P.d_skip[hd];
    float h[64];
#pragma unroll
    for (int n = 0; n < 64; ++n) h[n] = 0.f;
    float ux0 = 0.f, ux1 = 0.f, ux2 = 0.f, uB0 = 0.f, uB1 = 0.f, uB2 = 0.f, uC0 = 0.f, uC1 = 0.f, uC2 = 0.f;
    for (int t = 0; t < SEQ; ++t) {
        const size_t row = (size_t)b * SEQ + t;
        const bf16_t* ur = U0 + row * U0P + COL_XBC;
        const float x3 = bf2f(ur[cx]), b3 = bf2f(ur[cB]), c3 = bf2f(ur[cC]);
        const float xc = silu_f(bx + wx[0] * ux0 + wx[1] * ux1 + wx[2] * ux2 + wx[3] * x3);
        const float Bc = silu_f(bB + wB[0] * uB0 + wB[1] * uB1 + wB[2] * uB2 + wB[3] * b3);
        const float Cc = silu_f(bC + wC[0] * uC0 + wC[1] * uC1 + wC[2] * uC2 + wC[3] * c3);
        ux0 = ux1; ux1 = ux2; ux2 = x3; uB0 = uB1; uB1 = uB2; uB2 = b3; uC0 = uC1; uC1 = uC2; uC2 = c3;
        WAVE_SYNC();
        sB[p] = Bc; sC[p] = Cc;
        WAVE_SYNC();
        const float dt = softplus_f(SM[row * 32 + hd] + dtb), dA = __expf(dt * a), xdt = xc * dt;
        float y = 0.f;
#pragma unroll
        for (int n = 0; n < 64; ++n) { h[n] = dA * h[n] + xdt * sB[n]; y += sC[n] * h[n]; if ((n & 7) == 7) asm volatile("" ::: "memory"); }
        y += Dk * xc;
        const float z = bf2f(U0[row * U0P + COL_Z + cx]);
        const float yg = y * silu_f(z);
        YG[row * 2048 + cx] = (bf16_t)f2bf(yg);
        const float s = wave_sum(yg * yg);
        if (p == 0) atomicAdd(&ssq[row], s);
    }
}
__device__ __forceinline__ void gla_naive_wave(const Params& P, int b, int h, int l, LAS float* sq, LAS float* sk, LAS float* sd) {
    const bf16_t* U0 = (const bf16_t*)(P.ws + WS_U); const float* SM = (const float*)(P.ws + WS_SM);
    bf16_t* YG = (bf16_t*)(P.ws + WS_YG);
    float w2[16];
#pragma unroll
    for (int r = 0; r < 16; ++r) w2[r] = P.gate_w2[r * 512 + h * 64 + l];
    const float gb = P.gate_b[h * 64 + l], nw0 = P.gla_norm[l], nw1 = P.gla_norm[l + 64];
    float S0[64], S1[64];
#pragma unroll
    for (int d = 0; d < 64; ++d) { S0[d] = 0.f; S1[d] = 0.f; }
    for (int t = 0; t < SEQ; ++t) {
        const size_t row = (size_t)b * SEQ + t;
        const bf16_t* ur = U0 + row * U0P;
        float pre = gb;
#pragma unroll
        for (int r = 0; r < 16; ++r) pre += SM[row * 32 + 16 + r] * w2[r];
        const float dec = __expf(logsigmoid_f(pre) * (1.0f / 16.0f));
        WAVE_SYNC();
        sq[l] = bf2f(ur[COL_Q + h * 64 + l]) * 0.125f; sk[l] = bf2f(ur[COL_K + h * 64 + l]); sd[l] = dec;
        WAVE_SYNC();
        const float v0 = bf2f(ur[COL_V + h * 128 + l]), v1 = bf2f(ur[COL_V + h * 128 + 64 + l]);
        float o0 = 0.f, o1 = 0.f;
#pragma unroll
        for (int d = 0; d < 64; ++d) { const float dd = sd[d], kk = sk[d], qq = sq[d]; S0[d] = dd * S0[d] + kk * v0; S1[d] = dd * S1[d] + kk * v1; o0 += qq * S0[d]; o1 += qq * S1[d]; if ((d & 7) == 7) asm volatile("" ::: "memory"); }
        const float rstd = 1.0f / sqrtf(wave_sum(o0 * o0 + o1 * o1) * (1.0f / 128.0f) + RMS_EPS);
        const float g0 = bf2f(ur[COL_G + h * 128 + l]), g1 = bf2f(ur[COL_G + h * 128 + 64 + l]);
        YG[row * 2048 + 1024 + h * 128 + l] = (bf16_t)f2bf(o0 * rstd * nw0 * silu_f(g0));
        YG[row * 2048 + 1024 + h * 128 + 64 + l] = (bf16_t)f2bf(o1 * rstd * nw1 * silu_f(g1));
    }
}
__device__ __forceinline__ void moba_naive_row(const Params& P, int b, int h, int nb, int tr, const LAS float* skm) {
    const bf16_t* U1 = (const bf16_t*)(P.ws + WS_U);
    bf16_t* O = (bf16_t*)(P.ws + WS_YG + 32 * MiB);
    const int t = nb * 256 + tr; const size_t row = (size_t)b * SEQ + t;
    float q[64];
    { const bf16_t* qp = U1 + row * 4096 + h * 64;
#pragma unroll
      for (int d = 0; d < 64; ++d) q[d] = bf2f(qp[d]); }
    float gate[8];
#pragma unroll
    for (int j = 0; j < 8; ++j) { float s = 0.f;
#pragma unroll
        for (int d = 0; d < 64; ++d) s += q[d] * skm[j * 64 + d];
        gate[j] = s; }
    unsigned sel = 0;
#pragma unroll
    for (int j = 0; j < 8; ++j) { if (j < nb) { int rank = 0;
#pragma unroll
            for (int i = 0; i < 8; ++i) if (i < nb && (gate[i] > gate[j] || (gate[i] == gate[j] && i < j))) ++rank;
            if (rank < 3) sel |= 1u << j; } }
    float m = -1e30f, lsum = 0.f, o[64];
#pragma unroll
    for (int d = 0; d < 64; ++d) o[d] = 0.f;
    for (int jj = 0; jj <= nb; ++jj) {
        const int j = (jj == 0) ? nb : jj - 1;
        const bool own = (j == nb);
        const bool lane_on = own || ((sel >> j) & 1u);
        if (!__any(lane_on)) continue;
        for (int kk = 0; kk < 256; ++kk) {
            const int key = j * 256 + kk;
            const bool ok = lane_on && (!own || key <= t);
            if (!__any(ok)) { if (own) break; else continue; }
            const bf16_t* kp = U1 + ((size_t)b * SEQ + key) * 4096 + 1024 + h * 64;
            const bf16_t* vp = kp + 1024;
            float s = 0.f;
#pragma unroll
            for (int d = 0; d < 64; ++d) s += q[d] * bf2f(kp[d]);
            if (ok) {
                const float mn = fmaxf(m, s), f = __builtin_amdgcn_exp2f(m - mn), pr = __builtin_amdgcn_exp2f(s - mn);
                lsum = lsum * f + pr; m = mn;
#pragma unroll
                for (int d = 0; d < 64; ++d) o[d] = o[d] * f + pr * bf2f(vp[d]);
            }
        }
    }
    const float inv = 1.0f / lsum;
    const bf16_t* zp = U1 + row * 4096 + 3072 + h * 64; bf16_t* op = O + row * 1024 + h * 64;
#pragma unroll
    for (int d = 0; d < 64; ++d) op[d] = (bf16_t)f2bf(o[d] * inv * bf2f(zp[d]));
}

namespace moba {
typedef short bf16x8 __attribute__((ext_vector_type(8)));
typedef short s16x4 __attribute__((ext_vector_type(4)));
typedef float f32x16 __attribute__((ext_vector_type(16)));
typedef float f32x2_t __attribute__((ext_vector_type(2)));
typedef __bf16 bf16x2_t __attribute__((ext_vector_type(2)));
typedef short v4i16_t __attribute__((ext_vector_type(4)));
typedef const LAS char* lds_cptr;
__device__ __forceinline__ int crow(int r, int hi) { return (r & 3) + 8 * (r >> 2) + 4 * hi; }
__device__ __forceinline__ unsigned cvtpk(float lo, float hi) { f32x2_t v = {lo, hi}; bf16x2_t b = __builtin_convertvector(v, bf16x2_t); return __builtin_bit_cast(unsigned, b); }
__device__ __forceinline__ s16x4 vtr(lds_cptr p) { return __builtin_bit_cast(s16x4, __builtin_amdgcn_ds_read_tr16_b64_v4i16((LAS v4i16_t*)p)); }
constexpr int L_K = 0, L_V = 16384, L_KS = 32768, L_BYTES = 32768 + 2048;

__device__ __forceinline__ void unit(const Params& P, int b, int h, int nb, LAS unsigned char* lds) {
    int tid_ = threadIdx.x; asm volatile("" : "+v"(tid_));
    const int tid = tid_, lane = tid & 63, r32 = lane & 31, hi = lane >> 5, wid = __builtin_amdgcn_readfirstlane(tid >> 6);
    const bf16_t* U1 = (const bf16_t*)(P.ws + WS_U);
    const size_t rowbase = (size_t)b * SEQ; const int q0 = nb * 256;
    { const float* ksum = (const float*)(P.ws + WS_CTL + CTL_KSUM); LAS float* sk = (LAS float*)(lds + L_KS);
      sk[tid] = ksum[(size_t)(b * 8 + (tid >> 6)) * 1024 + h * 64 + (tid & 63)]; }
    const bf16_t* ksrc0 = U1 + (rowbase + lane) * 4096 + 1024 + h * 64 + wid * 8;
    const bf16_t* vsrc0 = U1 + (rowbase + 16 * (wid & 3) + (lane >> 2)) * 4096 + 2048 + h * 64 + (wid >> 2) * 32 + (lane & 3) * 8;
    const int stoff = wid * 1024 + lane * 16;
    const int NT = 4 * (nb + 1);
#define MOBA_TILE_ROW(s) (((s) < 4) ? (q0 + (s) * 64) : ((((s) - 4) >> 2) * 256 + (((s) - 4) & 3) * 64))
    v4u kreg, vreg;
    { const size_t ro = (size_t)MOBA_TILE_ROW(0) * 4096; kreg = *(const v4u*)(ksrc0 + ro); vreg = *(const v4u*)(vsrc0 + ro); }
    const bf16_t* Qw = U1 + (rowbase + q0 + wid * 32 + r32) * 4096 + h * 64;
    bf16x8 qr[4];
#pragma unroll
    for (int d0 = 0; d0 < 4; ++d0) qr[d0] = *(const bf16x8*)(Qw + d0 * 16 + hi * 8);
    *(LAS v4u*)(lds + L_K + stoff) = kreg; *(LAS v4u*)(lds + L_V + stoff) = vreg;
    __syncthreads();
    unsigned sel = 0;
    if (nb > 0) {
        const LAS float* sk = (const LAS float*)(lds + L_KS);
        float gate[8];
#pragma unroll
        for (int j = 0; j < 7; ++j) { float s = 0.f;
            if (j < nb) {
#pragma unroll
                for (int d0 = 0; d0 < 4; ++d0)
#pragma unroll
                    for (int e = 0; e < 8; ++e) s += bf2f((unsigned short)qr[d0][e]) * sk[j * 64 + d0 * 16 + hi * 8 + e];
                s += __shfl_xor(s, 32); }
            gate[j] = s; }
        gate[7] = 0.f;
#pragma unroll
        for (int j = 0; j < 7; ++j) { if (j < nb) { int rank = 0;
#pragma unroll
                for (int i = 0; i < 7; ++i) if (i < nb && (gate[i] > gate[j] || (gate[i] == gate[j] && i < j))) ++rank;
                if (rank < 3) sel |= 1u << j; } }
    }
    float m = -INFINITY, l = 0.f; f32x16 o0 = {}, o1 = {};
    const int qloc = wid * 32 + r32;
    const lds_cptr vp0 = (lds_cptr)lds + L_V + ((lane >> 4) & 1) * 32 + (lane & 3) * 8 + (4 * hi + ((lane & 15) >> 2)) * 64;
    const lds_cptr kp0 = (lds_cptr)lds + L_K + hi * 1024 + r32 * 16;
    for (int s = 0; s < NT; ++s) {
        const bool has_next = (s + 1) < NT;
        if (has_next) { const size_t ro = (size_t)MOBA_TILE_ROW(s + 1) * 4096; kreg = *(const v4u*)(ksrc0 + ro); vreg = *(const v4u*)(vsrc0 + ro); }
        const bool own = s < 4; const int kt = own ? s : ((s - 4) & 3); const int jb = own ? nb : ((s - 4) >> 2);
        const bool lane_on = own || ((sel >> jb) & 1u);
        const bool active = own ? (kt * 64 <= wid * 32 + 31) : (__any(lane_on) != 0);
        if (active) {
            const lds_cptr kp = kp0 + (s & 1) * 8192; const lds_cptr vp = vp0 + (s & 1) * 8192;
            f32x16 p0 = {}, p1 = {};
#pragma unroll
            for (int d0 = 0; d0 < 4; ++d0) {
                const bf16x8 k0 = *(const LAS bf16x8*)(kp + d0 * 2048), k1 = *(const LAS bf16x8*)(kp + d0 * 2048 + 512);
                p0 = __builtin_amdgcn_mfma_f32_32x32x16_bf16(k0, qr[d0], p0, 0, 0, 0);
                p1 = __builtin_amdgcn_mfma_f32_32x32x16_bf16(k1, qr[d0], p1, 0, 0, 0); }
            if (own && kt == (wid >> 1)) {
#pragma unroll
                for (int r = 0; r < 16; ++r) { const int key = kt * 64 + crow(r, hi); if (key > qloc) p0[r] = -INFINITY; if (key + 32 > qloc) p1[r] = -INFINITY; }
            }
            if (!own) {
#pragma unroll
                for (int r = 0; r < 16; ++r) { p0[r] = lane_on ? p0[r] : -INFINITY; p1[r] = lane_on ? p1[r] : -INFINITY; }
            }
            float rm = fmaxf(p0[0], p1[0]);
#pragma unroll
            for (int r = 1; r < 16; ++r) rm = fmaxf(rm, fmaxf(p0[r], p1[r]));
            rm = fmaxf(rm, __shfl_xor(rm, 32));
            const float mn = fmaxf(m, rm), alpha = __builtin_amdgcn_exp2f(m - mn);
            m = mn;
            float rs = 0.f;
#pragma unroll
            for (int r = 0; r < 16; ++r) { p0[r] = __builtin_amdgcn_exp2f(p0[r] - mn); p1[r] = __builtin_amdgcn_exp2f(p1[r] - mn); rs += p0[r] + p1[r]; }
            rs += __shfl_xor(rs, 32);
            l = l * alpha + rs;
#pragma unroll
            for (int r = 0; r < 16; ++r) { o0[r] *= alpha; o1[r] *= alpha; }
            v4u pw[4];
#pragma unroll
            for (int e = 0; e < 4; ++e) { pw[0][e] = cvtpk(p0[2 * e], p0[2 * e + 1]); pw[1][e] = cvtpk(p0[8 + 2 * e], p0[8 + 2 * e + 1]); pw[2][e] = cvtpk(p1[2 * e], p1[2 * e + 1]); pw[3][e] = cvtpk(p1[8 + 2 * e], p1[8 + 2 * e + 1]); }
#pragma unroll
            for (int ks = 0; ks < 4; ++ks) {
                const s16x4 a0 = vtr(vp + ks * 1024), a1 = vtr(vp + ks * 1024 + 512), c0 = vtr(vp + 4096 + ks * 1024), c1 = vtr(vp + 4096 + ks * 1024 + 512);
                const bf16x8 v0 = (bf16x8){a0[0], a0[1], a0[2], a0[3], a1[0], a1[1], a1[2], a1[3]}, v1 = (bf16x8){c0[0], c0[1], c0[2], c0[3], c1[0], c1[1], c1[2], c1[3]};
                const bf16x8 pf = __builtin_bit_cast(bf16x8, pw[ks]);
                o0 = __builtin_amdgcn_mfma_f32_32x32x16_bf16(v0, pf, o0, 0, 0, 0);
                o1 = __builtin_amdgcn_mfma_f32_32x32x16_bf16(v1, pf, o1, 0, 0, 0); }
        }
        if (has_next) { *(LAS v4u*)(lds + L_K + ((s + 1) & 1) * 8192 + stoff) = kreg; *(LAS v4u*)(lds + L_V + ((s + 1) & 1) * 8192 + stoff) = vreg; }
        __syncthreads();
    }
#undef MOBA_TILE_ROW
    const float inv = 1.0f / l;
    const size_t row = rowbase + q0 + wid * 32 + r32;
    const bf16_t* zp = U1 + row * 4096 + 3072 + h * 64; bf16_t* op = (bf16_t*)(P.ws + WS_YG + 32 * MiB) + row * 1024 + h * 64;
#pragma unroll
    for (int g = 0; g < 4; ++g) {
        const int d = 8 * g + 4 * hi;
        const v2u z0 = *(const v2u*)(zp + d), z1 = *(const v2u*)(zp + 32 + d);
        v2u w0, w1;
        w0.x = cvtpk(o0[4 * g] * inv * bf2f(z0.x & 0xffffu), o0[4 * g + 1] * inv * bf2f(z0.x >> 16)); w0.y = cvtpk(o0[4 * g + 2] * inv * bf2f(z0.y & 0xffffu), o0[4 * g + 3] * inv * bf2f(z0.y >> 16));
        w1.x = cvtpk(o1[4 * g] * inv * bf2f(z1.x & 0xffffu), o1[4 * g + 1] * inv * bf2f(z1.x >> 16)); w1.y = cvtpk(o1[4 * g + 2] * inv * bf2f(z1.y & 0xffffu), o1[4 * g + 3] * inv * bf2f(z1.y >> 16));
        *(v2u*)(op + d) = w0; *(v2u*)(op + 32 + d) = w1;
    }
    __syncthreads();
}
__device__ __forceinline__ void phase(const Params& P, LAS unsigned char* lds, int G, int bx) {
    if (G == 256) {
        const int vcu = (bx % 8) * (G / 8) + bx / 8, bh = vcu >> 1, odd = vcu & 1;
        for (int i = 0; i < 4; ++i) { const int nb = odd ? ((i == 0) ? 6 : (i == 1) ? 1 : (i == 2) ? 4 : 3) : ((i == 0) ? 7 : (i == 1) ? 0 : (i == 2) ? 5 : 2);
            unit(P, bh >> 4, bh & 15, nb, lds); }
    } else {
        for (int u = bx; u < BATCH * 16 * 8; u += G) unit(P, u / 128, (u / 8) % 16, u % 8, lds);
    }
}
}
namespace mix {
using moba::bf16x8; using moba::s16x4; using moba::f32x16; using moba::lds_cptr; using moba::cvtpk; using moba::vtr;
constexpr float LOG2E = 1.4426950408889634f;
__device__ __forceinline__ bf16x8 trfrag(lds_cptr p) { const s16x4 a = vtr(p), c = vtr(p + 512); return (bf16x8){a[0], a[1], a[2], a[3], c[0], c[1], c[2], c[3]}; }
__device__ __forceinline__ v4u pack8(const float* v) { v4u o; o.x = cvtpk(v[0], v[1]); o.y = cvtpk(v[2], v[3]); o.z = cvtpk(v[4], v[5]); o.w = cvtpk(v[6], v[7]); return o; }
__device__ __forceinline__ float silu_fast(float x) { return x * __builtin_amdgcn_rcpf(1.f + __builtin_amdgcn_exp2f(-LOG2E * x)); }

constexpr int S_X = 0, S_BM = 16384, S_BW = 32768, S_CM = 49152, S_SB = 65536, S_ACS = 73728, S_DT = S_ACS + 512, S_E = S_DT + 512, S_W = S_E + 512, S_AL = S_W + 512, S_CW = S_AL + 16, S_END = S_CW + 3840;
__device__ __forceinline__ void ssd_unit(const Params& P, int b, int hd, LAS unsigned char* lds) {
    int tid_ = threadIdx.x; asm volatile("" : "+v"(tid_));
    const int tid = tid_, lane = tid & 63, r32 = lane & 31, hi = lane >> 5, wid = __builtin_amdgcn_readfirstlane(tid >> 6);
    const int g = hd >> 3, it = wid >> 1, pt = wid & 1;
    const bf16_t* U0 = (const bf16_t*)(P.ws + WS_U); const float* SM = (const float*)(P.ws + WS_SM);
    bf16_t* YG = (bf16_t*)(P.ws + WS_YG); float* ssq = (float*)(P.ws + WS_CTL + CTL_SSQ);
    const float a = -__expf(P.a_log[hd]), dtb = P.dt_bias[hd], Dk = P.d_skip[hd];
    const size_t rowbase = (size_t)b * SEQ;
    LAS float* cw = (LAS float*)(lds + S_CW);
    for (int i = tid; i < 960; i += 512) { const int k = i / 192, cc = i % 192; const int ch = cc < 64 ? hd * 64 + cc : (cc < 128 ? 1024 + g * 64 + cc - 64 : 1152 + g * 64 + cc - 128); cw[i] = k < 4 ? P.conv_w[k * 1280 + ch] : P.conv_b[ch]; }
    for (int i = tid; i < 8192 / 16; i += 512) *(LAS v4u*)(lds + S_SB + i * 16) = (v4u){0u, 0u, 0u, 0u};
    LAS float* acsL = (LAS float*)(lds + S_ACS); LAS float* dtL = (LAS float*)(lds + S_DT); LAS float* eL = (LAS float*)(lds + S_E); LAS float* wL = (LAS float*)(lds + S_W); LAS float* alL = (LAS float*)(lds + S_AL);
    const int vlane = ((lane >> 4) & 1) * 32 + (lane & 3) * 8 + (4 * hi + ((lane & 15) >> 2)) * 64;
    const lds_cptr Xl = (lds_cptr)lds + S_X + vlane, Bwl = (lds_cptr)lds + S_BW + vlane;
    const int icol = 32 * it + r32, prow = 32 * pt + r32;
    f32x16 S = {};
    for (int c = 0; c < 16; ++c) {
        const int t0 = c * 128;
        if (wid == 0) {
            const float d0 = softplus_f(SM[(rowbase + t0 + 2 * lane) * 32 + hd] + dtb), d1 = softplus_f(SM[(rowbase + t0 + 2 * lane + 1) * 32 + hd] + dtb);
            const float v0 = d0 * a, v1 = d1 * a;
            float inc = v0 + v1;
#pragma unroll
            for (int o = 1; o < 64; o <<= 1) { const float t = __shfl_up(inc, o); if (lane >= o) inc += t; }
            const float al = __shfl(inc, 63), c1 = inc, c0 = inc - v1;
            acsL[2 * lane] = c0; acsL[2 * lane + 1] = c1; dtL[2 * lane] = d0; dtL[2 * lane + 1] = d1;
            eL[2 * lane] = __expf(c0); eL[2 * lane + 1] = __expf(c1); wL[2 * lane] = __expf(al - c0) * d0; wL[2 * lane + 1] = __expf(al - c1) * d1;
            if (lane == 0) alL[0] = al;
        }
        __syncthreads();
#pragma unroll 2
        for (int k = 0; k < 6; ++k) {
            const int item = tid + 512 * k, c8 = item % 24, t = item / 24;
            const int kind = c8 >> 3, cc = c8 * 8;
            const int ch = kind == 0 ? hd * 64 + cc : (kind == 1 ? 1024 + g * 64 + cc - 64 : 1152 + g * 64 + cc - 128);
            const bf16_t* up = U0 + (rowbase + t0 + t) * U0P + COL_XBC + ch;
            float acc[8];
            { const v4f b0 = *(const LAS v4f*)(cw + 4 * 192 + cc), b1 = *(const LAS v4f*)(cw + 4 * 192 + cc + 4); acc[0] = b0.x; acc[1] = b0.y; acc[2] = b0.z; acc[3] = b0.w; acc[4] = b1.x; acc[5] = b1.y; acc[6] = b1.z; acc[7] = b1.w; }
#pragma unroll
            for (int kk = 0; kk < 4; ++kk) {
                v4u u = (v4u){0u, 0u, 0u, 0u};
                if (t0 + t - 3 + kk >= 0) u = *(const v4u*)(up - (ptrdiff_t)(3 - kk) * U0P);
                const v4f w0 = *(const LAS v4f*)(cw + kk * 192 + cc), w1 = *(const LAS v4f*)(cw + kk * 192 + cc + 4);
                acc[0] += w0.x * bf2f(u.x & 0xffffu); acc[1] += w0.y * bf2f(u.x >> 16); acc[2] += w0.z * bf2f(u.y & 0xffffu); acc[3] += w0.w * bf2f(u.y >> 16);
                acc[4] += w1.x * bf2f(u.z & 0xffffu); acc[5] += w1.y * bf2f(u.z >> 16); acc[6] += w1.z * bf2f(u.w & 0xffffu); acc[7] += w1.w * bf2f(u.w >> 16);
            }
#pragma unroll
            for (int e = 0; e < 8; ++e) acc[e] = silu_fast(acc[e]);
            const int c8l = c8 & 7;
            const int voff = ((c8l >> 2) * 8 + (t >> 4)) * 1024 + (t & 15) * 64 + (c8l & 3) * 16, koff = c8l * 2048 + t * 16;
            if (kind == 0) *(LAS v4u*)(lds + S_X + voff) = pack8(acc);
            else if (kind == 2) *(LAS v4u*)(lds + S_CM + koff) = pack8(acc);
            else { *(LAS v4u*)(lds + S_BM + koff) = pack8(acc); const float w = wL[t];
#pragma unroll
                for (int e = 0; e < 8; ++e) acc[e] *= w;
                *(LAS v4u*)(lds + S_BW + voff) = pack8(acc); }
        }
        __syncthreads();
        {
            bf16x8 cf[4];
#pragma unroll
            for (int d0 = 0; d0 < 4; ++d0) cf[d0] = *(const LAS bf16x8*)(lds + S_CM + (2 * d0 + hi) * 2048 + icol * 16);
            f32x16 Y = {};
#pragma unroll
            for (int d0 = 0; d0 < 4; ++d0) { const bf16x8 sf = *(const LAS bf16x8*)(lds + S_SB + (2 * d0 + hi) * 1024 + prow * 16); Y = __builtin_amdgcn_mfma_f32_32x32x16_bf16(sf, cf[d0], Y, 0, 0, 0); }
            const float acs_i = acsL[icol], e_i = eL[icol];
#pragma unroll
            for (int r = 0; r < 16; ++r) Y[r] *= e_i;
            for (int jt = 0; jt <= it; ++jt) {
                f32x16 cb = {};
#pragma unroll
                for (int d0 = 0; d0 < 4; ++d0) { const bf16x8 bf = *(const LAS bf16x8*)(lds + S_BM + (2 * d0 + hi) * 2048 + (32 * jt + r32) * 16); cb = __builtin_amdgcn_mfma_f32_32x32x16_bf16(bf, cf[d0], cb, 0, 0, 0); }
                const bool diag = (jt == it);
#pragma unroll
                for (int q = 0; q < 4; ++q) {
                    const v4f aj = *(const LAS v4f*)(acsL + 32 * jt + 8 * q + 4 * hi), dj = *(const LAS v4f*)(dtL + 32 * jt + 8 * q + 4 * hi);
#pragma unroll
                    for (int e = 0; e < 4; ++e) { const float mv = cb[4 * q + e] * __builtin_amdgcn_exp2f((acs_i - aj[e]) * LOG2E) * dj[e]; cb[4 * q + e] = (diag && (8 * q + 4 * hi + e) > r32) ? 0.f : mv; }
                }
                v4u pw0, pw1;
#pragma unroll
                for (int e = 0; e < 4; ++e) { pw0[e] = cvtpk(cb[2 * e], cb[2 * e + 1]); pw1[e] = cvtpk(cb[8 + 2 * e], cb[8 + 2 * e + 1]); }
                const bf16x8 x0 = trfrag(Xl + pt * 8192 + (2 * jt) * 1024), x1 = trfrag(Xl + pt * 8192 + (2 * jt + 1) * 1024);
                Y = __builtin_amdgcn_mfma_f32_32x32x16_bf16(x0, __builtin_bit_cast(bf16x8, pw0), Y, 0, 0, 0);
                Y = __builtin_amdgcn_mfma_f32_32x32x16_bf16(x1, __builtin_bit_cast(bf16x8, pw1), Y, 0, 0, 0);
            }
            const size_t row = rowbase + t0 + icol;
            float ssum = 0.f;
#pragma unroll
            for (int q = 0; q < 4; ++q) {
                const int pc = 8 * q + 4 * hi;
                const v2u xx = *(const LAS v2u*)(lds + S_X + (pt * 8 + (icol >> 4)) * 1024 + (icol & 15) * 64 + pc * 2);
                const v2u zz = *(const v2u*)(U0 + row * U0P + COL_Z + hd * 64 + 32 * pt + pc);
                const float y0 = (Y[4 * q] + Dk * bf2f(xx.x & 0xffffu)) * silu_fast(bf2f(zz.x & 0xffffu)), y1 = (Y[4 * q + 1] + Dk * bf2f(xx.x >> 16)) * silu_fast(bf2f(zz.x >> 16));
                const float y2 = (Y[4 * q + 2] + Dk * bf2f(xx.y & 0xffffu)) * silu_fast(bf2f(zz.y & 0xffffu)), y3 = (Y[4 * q + 3] + Dk * bf2f(xx.y >> 16)) * silu_fast(bf2f(zz.y >> 16));
                ssum += (y0 * y0 + y1 * y1) + (y2 * y2 + y3 * y3);
                v2u w; w.x = cvtpk(y0, y1); w.y = cvtpk(y2, y3);
                *(v2u*)(YG + row * 2048 + hd * 64 + 32 * pt + pc) = w;
            }
            ssum += __shfl_xor(ssum, 32);
            if (hi == 0) atomicAdd(&ssq[row], ssum);
        }
        if (wid < 4) {
            const float dA = __expf(alL[0]);
#pragma unroll
            for (int r = 0; r < 16; ++r) S[r] *= dA;
#pragma unroll
            for (int ks = 0; ks < 8; ++ks) { const bf16x8 af = trfrag(Bwl + it * 8192 + ks * 1024), xf = trfrag(Xl + pt * 8192 + ks * 1024); S = __builtin_amdgcn_mfma_f32_32x32x16_bf16(af, xf, S, 0, 0, 0); }
        }
        __syncthreads();
        if (wid < 4) {
#pragma unroll
            for (int q = 0; q < 4; ++q) { v2u w; w.x = cvtpk(S[4 * q], S[4 * q + 1]); w.y = cvtpk(S[4 * q + 2], S[4 * q + 3]); *(LAS v2u*)(lds + S_SB + (4 * it + q) * 1024 + prow * 16 + hi * 8) = w; }
        }
    }
    __syncthreads();
}

constexpr int G_QT = 0, G_KT = 8192, G_QG = 16384, G_KW = 24576, G_V = 32768, G_ST = 49152, G_GCS = 65536, G_TOT = 81920, G_REF = G_TOT + 2048, G_GL = G_REF + 256, G_EGL = G_GL + 256, G_SS = G_EGL + 256, G_END = G_SS + 1024;
__device__ __forceinline__ void gla_unit(const Params& P, int b, int h, LAS unsigned char* lds) {
    int tid_ = threadIdx.x; asm volatile("" : "+v"(tid_));
    const int tid = tid_, lane = tid & 63, r32 = lane & 31, hi = lane >> 5, wid = __builtin_amdgcn_readfirstlane(tid >> 6);
    const int vt = wid >> 1, it = wid & 1;
    const bf16_t* U0 = (const bf16_t*)(P.ws + WS_U); const float* SM = (const float*)(P.ws + WS_SM);
    bf16_t* YG = (bf16_t*)(P.ws + WS_YG);
    const size_t rowbase = (size_t)b * SEQ;
    float w2[16];
#pragma unroll
    for (int r = 0; r < 16; ++r) w2[r] = P.gate_w2[r * 512 + h * 64 + lane];
    const float gb = P.gate_b[h * 64 + lane];
    for (int i = tid; i < 16384 / 16; i += 512) *(LAS v4u*)(lds + G_ST + i * 16) = (v4u){0u, 0u, 0u, 0u};
    LAS float* gcsL = (LAS float*)(lds + G_GCS); LAS float* totL = (LAS float*)(lds + G_TOT); LAS float* refL = (LAS float*)(lds + G_REF); LAS float* glL = (LAS float*)(lds + G_GL); LAS float* eglL = (LAS float*)(lds + G_EGL); LAS float* ssL = (LAS float*)(lds + G_SS);
    const int vlane = ((lane >> 4) & 1) * 32 + (lane & 3) * 8 + (4 * hi + ((lane & 15) >> 2)) * 64;
    const lds_cptr Vl = (lds_cptr)lds + G_V + vlane, KWl = (lds_cptr)lds + G_KW + vlane;
    const int icol = 32 * it + r32, vrow = 32 * vt + r32;
    f32x16 S = {};
    for (int c = 0; c < 32; ++c) {
        const int t0 = c * 64;
        float loc[8];
        {
            float run = 0.f;
#pragma unroll
            for (int tt = 0; tt < 8; ++tt) {
                const float* gl = SM + (rowbase + t0 + 8 * wid + tt) * 32 + 16;
                float pre = gb;
#pragma unroll
                for (int r = 0; r < 16; ++r) pre += gl[r] * w2[r];
                run += logsigmoid_f(pre) * (1.0f / 16.0f);
                loc[tt] = run;
            }
            totL[wid * 64 + lane] = run;
        }
        __syncthreads();
        {
            float off = 0.f, ref = 0.f, gl = 0.f;
#pragma unroll
            for (int w = 0; w < 8; ++w) { const float t = totL[w * 64 + lane]; if (w < wid) off += t; if (w < 4) ref += t; gl += t; }
#pragma unroll
            for (int tt = 0; tt < 8; ++tt) gcsL[(8 * wid + tt) * 64 + lane] = off + loc[tt];
            if (wid == 0) { refL[lane] = ref; glL[lane] = gl; eglL[lane] = __expf(gl); }
        }
        __syncthreads();
        {
            const int t = tid >> 3, c8 = tid & 7;
            const bf16_t* ur = U0 + (rowbase + t0 + t) * U0P;
            const v4u qv = *(const v4u*)(ur + COL_Q + h * 64 + c8 * 8), kv = *(const v4u*)(ur + COL_K + h * 64 + c8 * 8);
            float gc[8], rf[8], gl[8], q[8], k[8], o[8];
            { const v4f a0 = *(const LAS v4f*)(gcsL + t * 64 + c8 * 8), a1 = *(const LAS v4f*)(gcsL + t * 64 + c8 * 8 + 4); gc[0] = a0.x; gc[1] = a0.y; gc[2] = a0.z; gc[3] = a0.w; gc[4] = a1.x; gc[5] = a1.y; gc[6] = a1.z; gc[7] = a1.w; }
            { const v4f a0 = *(const LAS v4f*)(refL + c8 * 8), a1 = *(const LAS v4f*)(refL + c8 * 8 + 4); rf[0] = a0.x; rf[1] = a0.y; rf[2] = a0.z; rf[3] = a0.w; rf[4] = a1.x; rf[5] = a1.y; rf[6] = a1.z; rf[7] = a1.w; }
            { const v4f a0 = *(const LAS v4f*)(glL + c8 * 8), a1 = *(const LAS v4f*)(glL + c8 * 8 + 4); gl[0] = a0.x; gl[1] = a0.y; gl[2] = a0.z; gl[3] = a0.w; gl[4] = a1.x; gl[5] = a1.y; gl[6] = a1.z; gl[7] = a1.w; }
            q[0] = bf2f(qv.x & 0xffffu); q[1] = bf2f(qv.x >> 16); q[2] = bf2f(qv.y & 0xffffu); q[3] = bf2f(qv.y >> 16); q[4] = bf2f(qv.z & 0xffffu); q[5] = bf2f(qv.z >> 16); q[6] = bf2f(qv.w & 0xffffu); q[7] = bf2f(qv.w >> 16);
            k[0] = bf2f(kv.x & 0xffffu); k[1] = bf2f(kv.x >> 16); k[2] = bf2f(kv.y & 0xffffu); k[3] = bf2f(kv.y >> 16); k[4] = bf2f(kv.z & 0xffffu); k[5] = bf2f(kv.z >> 16); k[6] = bf2f(kv.w & 0xffffu); k[7] = bf2f(kv.w >> 16);
            const int koff = c8 * 1024 + t * 16, voff = ((c8 >> 2) * 4 + (t >> 4)) * 1024 + (t & 15) * 64 + (c8 & 3) * 16;
#pragma unroll
            for (int e = 0; e < 8; ++e) o[e] = q[e] * 0.125f * __builtin_amdgcn_exp2f((gc[e] - rf[e]) * LOG2E);
            *(LAS v4u*)(lds + G_QT + koff) = pack8(o);
#pragma unroll
            for (int e = 0; e < 8; ++e) o[e] = k[e] * __builtin_amdgcn_exp2f((rf[e] - gc[e]) * LOG2E);
            *(LAS v4u*)(lds + G_KT + koff) = pack8(o);
#pragma unroll
            for (int e = 0; e < 8; ++e) o[e] = q[e] * 0.125f * __builtin_amdgcn_exp2f(gc[e] * LOG2E);
            *(LAS v4u*)(lds + G_QG + koff) = pack8(o);
#pragma unroll
            for (int e = 0; e < 8; ++e) o[e] = k[e] * __builtin_amdgcn_exp2f((gl[e] - gc[e]) * LOG2E);
            *(LAS v4u*)(lds + G_KW + voff) = pack8(o);
#pragma unroll
            for (int kk = 0; kk < 2; ++kk) { const int item = tid + 512 * kk, tv = item >> 4, cv = item & 15;
                const v4u vv = *(const v4u*)(U0 + (rowbase + t0 + tv) * U0P + COL_V + h * 128 + cv * 8);
                *(LAS v4u*)(lds + G_V + ((cv >> 2) * 4 + (tv >> 4)) * 1024 + (tv & 15) * 64 + (cv & 3) * 16) = vv; }
        }
        __syncthreads();
        f32x16 O = {};
        {
            bf16x8 qf[4];
#pragma unroll
            for (int d0 = 0; d0 < 4; ++d0) { const bf16x8 sf = *(const LAS bf16x8*)(lds + G_ST + (2 * d0 + hi) * 2048 + vrow * 16), gq = *(const LAS bf16x8*)(lds + G_QG + (2 * d0 + hi) * 1024 + icol * 16);
                O = __builtin_amdgcn_mfma_f32_32x32x16_bf16(sf, gq, O, 0, 0, 0); qf[d0] = *(const LAS bf16x8*)(lds + G_QT + (2 * d0 + hi) * 1024 + icol * 16); }
            for (int jt = 0; jt <= it; ++jt) {
                f32x16 sc = {};
#pragma unroll
                for (int d0 = 0; d0 < 4; ++d0) { const bf16x8 kf = *(const LAS bf16x8*)(lds + G_KT + (2 * d0 + hi) * 1024 + (32 * jt + r32) * 16); sc = __builtin_amdgcn_mfma_f32_32x32x16_bf16(kf, qf[d0], sc, 0, 0, 0); }
                if (jt == it) {
#pragma unroll
                    for (int r = 0; r < 16; ++r) sc[r] = (moba::crow(r, hi) > r32) ? 0.f : sc[r];
                }
                v4u pw0, pw1;
#pragma unroll
                for (int e = 0; e < 4; ++e) { pw0[e] = cvtpk(sc[2 * e], sc[2 * e + 1]); pw1[e] = cvtpk(sc[8 + 2 * e], sc[8 + 2 * e + 1]); }
                const bf16x8 v0 = trfrag(Vl + vt * 4096 + (2 * jt) * 1024), v1 = trfrag(Vl + vt * 4096 + (2 * jt + 1) * 1024);
                O = __builtin_amdgcn_mfma_f32_32x32x16_bf16(v0, __builtin_bit_cast(bf16x8, pw0), O, 0, 0, 0);
                O = __builtin_amdgcn_mfma_f32_32x32x16_bf16(v1, __builtin_bit_cast(bf16x8, pw1), O, 0, 0, 0);
            }
            float ss = 0.f;
#pragma unroll
            for (int r = 0; r < 16; ++r) ss += O[r] * O[r];
            ss += __shfl_xor(ss, 32);
            if (hi == 0) ssL[vt * 64 + icol] = ss;
        }
        {
#pragma unroll
            for (int q = 0; q < 4; ++q) { const v4f eg = *(const LAS v4f*)(eglL + 32 * it + 8 * q + 4 * hi);
#pragma unroll
                for (int e = 0; e < 4; ++e) S[4 * q + e] *= eg[e]; }
#pragma unroll
            for (int ks = 0; ks < 4; ++ks) { const bf16x8 af = trfrag(KWl + it * 4096 + ks * 1024), vf = trfrag(Vl + vt * 4096 + ks * 1024); S = __builtin_amdgcn_mfma_f32_32x32x16_bf16(af, vf, S, 0, 0, 0); }
        }
        __syncthreads();
        {
            const float rstd = __builtin_amdgcn_rsqf((ssL[icol] + ssL[64 + icol] + ssL[128 + icol] + ssL[192 + icol]) * (1.0f / 128.0f) + RMS_EPS);
            const size_t row = rowbase + t0 + icol;
#pragma unroll
            for (int q = 0; q < 4; ++q) {
                const int vc = 32 * vt + 8 * q + 4 * hi;
                const v2u gg = *(const v2u*)(U0 + row * U0P + COL_G + h * 128 + vc);
                const v4f nw = *(const v4f*)(P.gla_norm + vc);
                v2u w; w.x = cvtpk(O[4 * q] * rstd * nw.x * silu_fast(bf2f(gg.x & 0xffffu)), O[4 * q + 1] * rstd * nw.y * silu_fast(bf2f(gg.x >> 16)));
                w.y = cvtpk(O[4 * q + 2] * rstd * nw.z * silu_fast(bf2f(gg.y & 0xffffu)), O[4 * q + 3] * rstd * nw.w * silu_fast(bf2f(gg.y >> 16)));
                *(v2u*)(YG + row * 2048 + 1024 + h * 128 + vc) = w;
            }
#pragma unroll
            for (int q = 0; q < 4; ++q) { v2u w; w.x = cvtpk(S[4 * q], S[4 * q + 1]); w.y = cvtpk(S[4 * q + 2], S[4 * q + 3]); *(LAS v2u*)(lds + G_ST + (4 * it + q) * 2048 + vrow * 16 + hi * 8) = w; }
        }
    }
    __syncthreads();
}
__device__ __forceinline__ void phase(const Params& P, LAS unsigned char* lds, int G, int bx) {
    if (G == 256) {
        const int vcu = (bx % 8) * 32 + bx / 8, x = vcu >> 5, li = vcu & 31;
        if (li < 16) ssd_unit(P, x, li, lds); else if (li < 24) gla_unit(P, x, li - 16, lds);
    } else {
        for (int u = bx; u < 192; u += G) { if (u < 128) ssd_unit(P, u >> 4, u & 15, lds); else gla_unit(P, (u - 128) >> 3, (u - 128) & 7, lds); }
    }
}
}
constexpr int RING_BYTES = 131072, LDSCTL_OFF = RING_BYTES, MISC_OFF = LDSCTL_OFF + 320, LDS_BYTES = 147456;
__global__ void __launch_bounds__(512, 2) mk_fwd(Params P) {
    extern __shared__ __attribute__((aligned(16))) unsigned char lds_raw[];
    LAS unsigned char* lds = (LAS unsigned char*)lds_raw;
    const int tid = threadIdx.x, lane = tid & 63, wave = __builtin_amdgcn_readfirstlane(tid >> 6);
    const int G = gridDim.x, gw = blockIdx.x * 8 + wave, NGW = G * 8;
    volatile LAS unsigned* MISC = (volatile LAS unsigned*)(lds + MISC_OFF);
    for (int u = tid; u < (LDS_BYTES - LDSCTL_OFF) / 4; u += 512) ((LAS unsigned*)(lds + LDSCTL_OFF))[u] = 0u;
    __syncthreads();
    unsigned char* ws = P.ws;
    XcdBarrier bar = xcd_barrier_post((unsigned*)(ws + WS_CTL + CTL_BAR), MISC + 8);

    { int t_ = threadIdx.x; asm volatile("" : "+v"(t_)); const int ln = t_ & 63, wv = __builtin_amdgcn_readfirstlane(t_ >> 6); p0_phase(P, lds, (int)blockIdx.x * 8 + wv, NGW, ln, wv); }
    xcd_barrier(bar);
    { pg8::Gemm g{(const bf16_t*)P.out, (const bf16_t*)(ws + WS_BT0), MTOK, N0, 1024, 0}; pg8::EpiU0 E{(bf16_t*)(ws + WS_U), (float*)(ws + WS_SM), -1, 0};
      pg8::StaticOrder S; S.init(MTOK, N0, G, (int)blockIdx.x);
#ifndef NO_G1
      pg8::gemm_phase<pg8::EpiU0, pg8::StaticOrder, true, true>(lds, g, S, E);
#endif
      }
    xcd_barrier(bar);
#ifdef MIX_NAIVE
    if (wave == 0) {
        const int unit = blockIdx.x;
#ifndef NO_SSD
        if (unit < 128) ssd_naive_wave(P, unit / 16, unit % 16, lane, (LAS float*)lds, (LAS float*)lds + 64);
#endif
#ifndef NO_GLA
        if (unit >= 128 && unit < 192) gla_naive_wave(P, (unit - 128) / 8, (unit - 128) % 8, lane, (LAS float*)lds, (LAS float*)lds + 64, (LAS float*)lds + 128);
#endif
    }
#else
    mix::phase(P, lds, G, (int)blockIdx.x);
#endif
    xcd_barrier(bar);
    { pg8::Gemm g{(const bf16_t*)(ws + WS_YG), (const bf16_t*)(ws + WS_BT1), MTOK, 1024, 2048, 0}; pg8::EpiRes<true> E{P.x, P.out, (const float*)(ws + WS_CTL + CTL_SSQ), 16, 0};
      pg8::StaticOrder S; S.init(MTOK, 1024, G, (int)blockIdx.x);
#ifndef NO_G2
      pg8::gemm_phase<pg8::EpiRes<true>, pg8::StaticOrder, true, true>(lds, g, S, E);
#endif
      }
    xcd_barrier(bar);
    { int t_ = threadIdx.x; asm volatile("" : "+v"(t_)); const int ln = t_ & 63, wv = __builtin_amdgcn_readfirstlane(t_ >> 6); p3b_phase(P, lds, (int)blockIdx.x * 8 + wv, NGW, ln, wv); }
    xcd_barrier(bar);
    { pg8::Gemm g{(const bf16_t*)(ws + WS_YG), (const bf16_t*)(ws + WS_BT2), MTOK, N1, 1024, 0}; pg8::EpiU1 E{(bf16_t*)(ws + WS_U), (float*)(ws + WS_CTL + CTL_KSUM), QK_C2, -1};
      pg8::StaticOrder S; S.init(MTOK, N1, G, (int)blockIdx.x);
#ifndef NO_G3
      pg8::gemm_phase<pg8::EpiU1, pg8::StaticOrder, true, true>(lds, g, S, E);
#endif
      }
    xcd_barrier(bar);
#ifdef MOBA_NAIVE
    for (int it = 0; it < (BATCH * 16 * 8) / (2 * G) + (((BATCH * 16 * 8) % (2 * G)) ? 1 : 0); ++it) {
        const int unit = (it * G + (int)blockIdx.x) * 2 + (tid >> 8);
        const bool live = unit < BATCH * 16 * 8;
        const int b = unit / 128, h = (unit / 8) % 16, nb = unit % 8;
        LAS float* skm = (LAS float*)lds + (tid >> 8) * 512;
        const float* ksum = (const float*)(ws + WS_CTL + CTL_KSUM);
        __syncthreads();
        if (live) for (int i = tid & 255; i < 512; i += 256) skm[i] = ksum[(size_t)(b * 8 + (i >> 6)) * 1024 + h * 64 + (i & 63)];
        __syncthreads();
#ifndef NO_MOBA
        if (live) moba_naive_row(P, b, h, nb, tid & 255, skm);
#endif
    }
#else
    moba::phase(P, lds, G, (int)blockIdx.x);
#endif
    xcd_barrier(bar);
    { pg8::Gemm g{(const bf16_t*)(ws + WS_YG + 32 * MiB), (const bf16_t*)(ws + WS_BT3), MTOK, 1024, 1024, 0}; pg8::EpiRes<false> E{P.out, P.out, nullptr, -1, 0};
      pg8::StaticOrder S; S.init(MTOK, 1024, G, (int)blockIdx.x);
#ifndef NO_G4
      pg8::gemm_phase<pg8::EpiRes<false>, pg8::StaticOrder, true, true>(lds, g, S, E);
#endif
      }
    xcd_barrier(bar);
    { int t_ = threadIdx.x; asm volatile("" : "+v"(t_)); const int ln = t_ & 63, wv = __builtin_amdgcn_readfirstlane(t_ >> 6);
      for (int m = (int)blockIdx.x * 8 + wv; m < MTOK; m += NGW) rms_row_f32(P.out + (size_t)m * 1024, P.final_norm, P.out + (size_t)m * 1024, ln); }
}

extern "C" void kernel_launch(void* const* d_in, const int* in_sizes, int n_in, void* d_out, int out_size, void* d_ws, size_t ws_size, hipStream_t stream) {
    static int grid = 0;
    if (grid == 0) {
        if (n_in != 17 || in_sizes[0] != MTOK * DM || out_size != MTOK * DM || ws_size < WS_END) { fprintf(stderr, "kernel_launch: unexpected shapes (n_in %d, in0 %d, out %d, ws %zu)\n", n_in, n_in > 0 ? in_sizes[0] : -1, out_size, ws_size); grid = -1; return; }
        int dev = 0, cus = 0, per_cu = 0;
        if (hipGetDevice(&dev) != hipSuccess || hipDeviceGetAttribute(&cus, hipDeviceAttributeMultiprocessorCount, dev) != hipSuccess) { grid = -1; return; }
        if (hipFuncSetAttribute((const void*)mk_fwd, hipFuncAttributeMaxDynamicSharedMemorySize, LDS_BYTES) != hipSuccess) { fprintf(stderr, "kernel_launch: hipFuncSetAttribute failed\n"); grid = -1; return; }
        if (hipOccupancyMaxActiveBlocksPerMultiprocessor(&per_cu, (const void*)mk_fwd, 512, LDS_BYTES) != hipSuccess || per_cu < 1) { fprintf(stderr, "kernel_launch: occupancy query says %d blocks per CU\n", per_cu); }
        (void)hipGetLastError();
        grid = cus;
    }
    if (grid < 0) return;
    if (hipMemsetAsync((char*)d_ws + WS_CTL, 0, CTL_BYTES, stream) != hipSuccess) return;
    Params P{};
    const float** pp = (const float**)&P;
    for (int i = 0; i < 17; ++i) pp[i] = (const float*)d_in[i];
    P.out = (float*)d_out; P.ws = (unsigned char*)d_ws;
    hipLaunchKernelGGL(mk_fwd, dim3(grid), dim3(512), LDS_BYTES, stream, P);
}
```

```cpp
#include <hip/hip_runtime.h>
#include <cstdio>
#include <cstdint>

constexpr int BATCH = 8, SEQ = 2048, DM = 1024, MTOK = BATCH * SEQ;
constexpr int N0 = 5632, U0P = 5376;
constexpr int COL_Z = 0, COL_XBC = 1024, COL_Q = 2304, COL_K = 2816, COL_V = 3328, COL_G = 4352;
constexpr int N1 = 4096, U1P = 4096 + 64;
constexpr float RMS_EPS = 1e-6f;
constexpr float QK_C2 = 0.125f * 1.4426950408889634f;
constexpr size_t MiB = 1u << 20;
constexpr size_t WS_CTL = 0, CTL_BYTES = 2 * MiB;
constexpr size_t WS_BT0 = 2 * MiB;
constexpr size_t WS_BT2 = 2 * MiB, WS_BT3 = 10 * MiB;
constexpr size_t WS_BT1 = 13 * MiB;
constexpr size_t WS_SM = 17 * MiB;
constexpr size_t WS_U = 19 * MiB;
constexpr size_t WS_YG = 187 * MiB;
constexpr size_t WS_END = 251 * MiB;
constexpr size_t CTL_SSQ = 64 * 1024;
constexpr size_t CTL_KSUM = 256 * 1024;
constexpr size_t CTL_BAR = 1024 * 1024;

#define LAS __attribute__((address_space(3)))
typedef unsigned short bf16_t;
typedef unsigned v4u __attribute__((ext_vector_type(4)));
typedef unsigned v2u __attribute__((ext_vector_type(2)));
typedef float v4f __attribute__((ext_vector_type(4)));

__device__ __forceinline__ unsigned f2bf(float f) { unsigned u = __builtin_bit_cast(unsigned, f); return (u + 0x7fffu + ((u >> 16) & 1u)) >> 16; }
__device__ __forceinline__ unsigned pk2(float lo, float hi) { return f2bf(lo) | (f2bf(hi) << 16); }
__device__ __forceinline__ float bf2f(unsigned h) { return __builtin_bit_cast(float, h << 16); }
__device__ __forceinline__ float silu_f(float x) { return x / (1.f + __expf(-x)); }
__device__ __forceinline__ float softplus_f(float x) { return x > 20.f ? x : log1pf(__expf(x)); }
__device__ __forceinline__ float logsigmoid_f(float x) { return fminf(x, 0.f) - log1pf(__expf(-fabsf(x))); }
__device__ __forceinline__ float wave_sum(float v) {
#pragma unroll
    for (int o = 1; o < 64; o <<= 1) v += __shfl_xor(v, o);
    return v;
}
namespace pg8 {
#define PG8_LAS __attribute__((address_space(3)))
typedef unsigned short bf16_t;
typedef short bf16x8 __attribute__((ext_vector_type(8)));
typedef float f32x4 __attribute__((ext_vector_type(4)));
typedef unsigned u32x4 __attribute__((ext_vector_type(4)));
constexpr int BM = 256, BK = 64, HALF = 128, HTB = HALF * BK * 2  , STAGE_BYTES = 8 * HTB, NXCD = 8, WGM = 8;

__host__ __device__ __forceinline__ int lds_byte(int r, int c) { const int st = (r >> 4) * 2 + (c >> 5), rr = r & 15, cc = c & 31, ob = rr * 64 + cc * 2; return st * 1024 + (ob ^ (((ob >> 9) & 1) << 5)); }
__host__ __device__ __forceinline__ void stage_rc(int b, int& R, int& C) { const int st = b / 1024, sb = b % 1024, swz = sb ^ (((sb >> 9) & 1) << 5); R = (st >> 1) * 16 + swz / 64; C = (st & 1) * 32 + (swz % 64) / 2; }
__host__ __device__ __forceinline__ int perm32(int rho) { const int n = rho >> 4, i = rho & 15; return 8 * (i >> 2) + 4 * n + (i & 3); }

struct Unit { int pm, pn; };
struct Gemm { const bf16_t* A; const bf16_t* Bt; int M, N, K, pad; };

struct StaticOrder {
    int nM, nN, nwg, G, c;
    __host__ __device__ void init(int M, int N, int G_, int c_) { nM = M / BM; nN = N / BM; nwg = nM * nN; G = G_; c = c_; }
    __host__ __device__ bool next(int i, Unit& u) const {
        const long L = (long)i * G + c; if (L >= nwg) return false;
        int wgid = (int)L; { const int q = nwg / NXCD, r = nwg % NXCD, xcd = wgid % NXCD, off = wgid / NXCD; wgid = (xcd < r ? xcd * (q + 1) : r * (q + 1) + (xcd - r) * q) + off; }
        const int nig = WGM * nN, gid = wgid / nig, fm = gid * WGM, gsz = (nM - fm) < WGM ? (nM - fm) : WGM;
        u.pm = fm + ((wgid % nig) % gsz); u.pn = (wgid % nig) / gsz; return true;
    }
    __device__ __forceinline__ void a_ready(const Unit&) const {}
    __device__ __forceinline__ void done(const Unit&) const {}
};

__device__ __forceinline__ unsigned cvt_pk_bf16(float lo, float hi) { unsigned r; asm volatile("v_cvt_pk_bf16_f32 %0, %1, %2" : "=v"(r) : "v"(lo), "v"(hi)); return r; }

struct EpiU0 {
    static constexpr bool PERM = true, AFTER_DRAIN = false, MIDK = false;
    bf16_t* U; float* SM; int midk_t, pad;
    __device__ __forceinline__ void midk(f32x4 (&)[2][2][4][2], const Unit&, int, int) const {}
    __device__ __forceinline__ void operator()(const f32x4 (&acc)[2][2][4][2], const Unit& u, int wr, int wc, int fr, int fq) const {
        const int row0 = u.pm * BM + wr * 64 + fr;
        if (u.pn < 21) {
            const int col0 = u.pn * BM + wc * 32 + 8 * fq;
#pragma unroll
            for (int ai = 0; ai < 2; ++ai)
#pragma unroll
                for (int m = 0; m < 4; ++m) { bf16_t* rowp = U + (size_t)(row0 + ai * HALF + m * 16) * 5376 + col0;
#pragma unroll
                    for (int bj = 0; bj < 2; ++bj) { const f32x4 v0 = acc[ai][bj][m][0], v1 = acc[ai][bj][m][1];
                        u32x4 w; w.x = cvt_pk_bf16(v0[0], v0[1]); w.y = cvt_pk_bf16(v0[2], v0[3]); w.z = cvt_pk_bf16(v1[0], v1[1]); w.w = cvt_pk_bf16(v1[2], v1[3]);
                        *(u32x4*)(rowp + bj * HALF) = w; } }
        } else if (wc == 0) {
#pragma unroll
            for (int ai = 0; ai < 2; ++ai)
#pragma unroll
                for (int m = 0; m < 4; ++m) { float* rp = SM + (size_t)(row0 + ai * HALF + m * 16) * 32 + 8 * fq;
                    *(f32x4*)rp = acc[ai][0][m][0]; *(f32x4*)(rp + 4) = acc[ai][0][m][1]; }
        }
    }
};
template <bool SCALE> struct EpiRes {
    static constexpr bool PERM = false, AFTER_DRAIN = false, MIDK = SCALE;
    const float* base; float* out; const float* ssq; int midk_t, pad;
    __device__ __forceinline__ void midk(f32x4 (&acc)[2][2][4][2], const Unit& u, int wr, int fr) const {
#pragma unroll
        for (int ai = 0; ai < 2; ++ai)
#pragma unroll
            for (int m = 0; m < 4; ++m) { const float s = __builtin_amdgcn_rsqf(ssq[u.pm * BM + ai * HALF + wr * 64 + m * 16 + fr] * (1.0f / 1024.0f) + 1e-6f);
#pragma unroll
                for (int bj = 0; bj < 2; ++bj)
#pragma unroll
                    for (int n = 0; n < 2; ++n) acc[ai][bj][m][n] *= s;
                asm volatile("" ::: "memory"); }
    }
    __device__ __forceinline__ void operator()(const f32x4 (&acc)[2][2][4][2], const Unit& u, int wr, int wc, int fr, int fq) const {
        const int col0 = u.pn * BM + wc * 32 + 4 * fq;
#pragma unroll
        for (int ai = 0; ai < 2; ++ai)
#pragma unroll
            for (int m = 0; m < 4; ++m) { const size_t off = (size_t)(u.pm * BM + ai * HALF + wr * 64 + m * 16 + fr) * 1024 + col0;
#pragma unroll
                for (int bj = 0; bj < 2; ++bj)
#pragma unroll
                    for (int n = 0; n < 2; ++n) { const f32x4 b = *(const f32x4*)(base + off + bj * HALF + n * 16); *(f32x4*)(out + off + bj * HALF + n * 16) = b + acc[ai][bj][m][n]; } }
    }
};
struct EpiU1 {
    static constexpr bool PERM = true, AFTER_DRAIN = false, MIDK = false;
    bf16_t* U; float* ksum; float qscale; int midk_t;
    __device__ __forceinline__ void midk(f32x4 (&)[2][2][4][2], const Unit&, int, int) const {}
    __device__ __forceinline__ void operator()(const f32x4 (&acc)[2][2][4][2], const Unit& u, int wr, int wc, int fr, int fq) const {
        const int row0 = u.pm * BM + wr * 64 + fr, col0 = u.pn * BM + wc * 32 + 8 * fq;
        const int kind = u.pn >> 2;
        const float sc = (kind == 0) ? qscale : 1.f;
#pragma unroll
        for (int ai = 0; ai < 2; ++ai)
#pragma unroll
            for (int m = 0; m < 4; ++m) { bf16_t* rowp = U + (size_t)(row0 + ai * HALF + m * 16) * U1P + col0;
#pragma unroll
                for (int bj = 0; bj < 2; ++bj) { f32x4 v0 = acc[ai][bj][m][0] * sc, v1 = acc[ai][bj][m][1] * sc;
                    if (kind == 3) {
#pragma unroll
                        for (int i = 0; i < 4; ++i) { v0[i] = v0[i] * __builtin_amdgcn_rcpf(1.f + __builtin_amdgcn_exp2f(-1.4426950408889634f * v0[i])); v1[i] = v1[i] * __builtin_amdgcn_rcpf(1.f + __builtin_amdgcn_exp2f(-1.4426950408889634f * v1[i])); } }
                    u32x4 w; w.x = cvt_pk_bf16(v0[0], v0[1]); w.y = cvt_pk_bf16(v0[2], v0[3]); w.z = cvt_pk_bf16(v1[0], v1[1]); w.w = cvt_pk_bf16(v1[2], v1[3]);
                    *(u32x4*)(rowp + bj * HALF) = w; } }
        if (kind == 1) {
            float* kp = ksum + (size_t)u.pm * 1024 + (col0 - 1024);
#pragma unroll
            for (int bj = 0; bj < 2; ++bj)
#pragma unroll
                for (int n = 0; n < 2; ++n) { f32x4 s = (f32x4){0.f, 0.f, 0.f, 0.f};
#pragma unroll
                    for (int ai = 0; ai < 2; ++ai)
#pragma unroll
                        for (int m = 0; m < 4; ++m) s += acc[ai][bj][m][n];
#pragma unroll
                    for (int i = 0; i < 4; ++i) { float t = s[i]; t += __shfl_xor(t, 1); t += __shfl_xor(t, 2); t += __shfl_xor(t, 4); t += __shfl_xor(t, 8); s[i] = t; }
                    if (fr == 0) {
#pragma unroll
                        for (int i = 0; i < 4; ++i) atomicAdd(kp + bj * HALF + 4 * n + i, s[i]); } }
        }
    }
};
template <class Epi, class Sched, bool ALIGN_EPI = false, bool SP2 = false>
__device__ __forceinline__ void gemm_phase(PG8_LAS unsigned char* lds, const Gemm g, const Sched& S, const Epi& E) {
    int tid_ = threadIdx.x; asm volatile("" : "+v"(tid_));
    const int tid = tid_, wid = __builtin_amdgcn_readfirstlane(tid >> 6), lane = tid & 63, wr = wid >> 2, wc = wid & 3, fr = lane & 15, fq = lane >> 4;
    const int K = g.K, nt = K / BK;
    unsigned voffA[2], voffB[2];
#pragma unroll
    for (int i = 0; i < 2; ++i) { int R, C; stage_rc(tid * 16 + i * 8192, R, C); const int Rb = Epi::PERM ? ((R & ~31) + perm32(R & 31)) : R;
        voffA[i] = (unsigned)(R * K + C) * 2u; voffB[i] = (unsigned)(Rb * K + C) * 2u; }
    const size_t kstep = (size_t)(BK * 2);
    const size_t hstep = (size_t)HALF * K * 2;
    const size_t tstep = 2 * hstep;
    const unsigned ldsw = (unsigned)wid * 1024u;
    const int aoff = lds_byte(wr * 64 + fr, fq * 8), boff = lds_byte(wc * 32 + fr, fq * 8);
#define PG8_SA(b, h) (((b) * 2 + (h)) * HTB)
#define PG8_SB(b, h) ((4 + (b) * 2 + (h)) * HTB)
#define PG8_STAGE(bufoff, gbase, voff) do { _Pragma("unroll") for (int _i = 0; _i < 2; ++_i) \
        __builtin_amdgcn_global_load_lds((const unsigned*)((const char*)(gbase) + (voff)[_i]), (PG8_LAS unsigned*)(lds + (bufoff) + ldsw + _i * 8192), 16, 0, 0); } while (0)
#define PG8_LDA(dst, b, h) do { _Pragma("unroll") for (int m = 0; m < 4; ++m) _Pragma("unroll") for (int k = 0; k < 2; ++k) dst[m][k] = *(const PG8_LAS bf16x8*)(lds + PG8_SA(b, h) + aoff + m * 2048 + k * 1024); } while (0)
#define PG8_LDB(dst, b, h) do { _Pragma("unroll") for (int n = 0; n < 2; ++n) _Pragma("unroll") for (int k = 0; k < 2; ++k) dst[n][k] = *(const PG8_LAS bf16x8*)(lds + PG8_SB(b, h) + boff + n * 2048 + k * 1024); } while (0)
#define PG8_MMA(ai, bj, At, Bt) do { __builtin_amdgcn_s_setprio(1); _Pragma("unroll") for (int m = 0; m < 4; ++m) _Pragma("unroll") for (int n = 0; n < 2; ++n) _Pragma("unroll") for (int k = 0; k < 2; ++k) \
        acc[ai][bj][m][n] = __builtin_amdgcn_mfma_f32_16x16x32_bf16(Bt[n][k], At[m][k], acc[ai][bj][m][n], 0, 0, 0); __builtin_amdgcn_s_setprio(0); } while (0)
#define PG8_WAIT_V(n) asm volatile("s_waitcnt vmcnt(" #n ")" ::: "memory")
#define PG8_WAIT_L(n) asm volatile("s_waitcnt lgkmcnt(" #n ")" ::: "memory")
#define PG8_BAR __builtin_amdgcn_s_barrier()
#define PG8_SCHED __builtin_amdgcn_sched_barrier(0)
    Unit cur, nxt; int ui = 0;
    if (!S.next(0, cur)) return;
    f32x4 acc[2][2][4][2];
#pragma unroll
    for (int a = 0; a < 2; ++a)
#pragma unroll
        for (int b = 0; b < 2; ++b)
#pragma unroll
            for (int m = 0; m < 4; ++m)
#pragma unroll
                for (int n = 0; n < 2; ++n) acc[a][b][m][n] = (f32x4){0.f, 0.f, 0.f, 0.f};
    bf16x8 At[4][2], B0[2][2], B1[2][2];
    const char* cA = (const char*)g.A + (size_t)cur.pm * tstep; const char* cB = (const char*)g.Bt + (size_t)cur.pn * tstep;
    S.a_ready(cur);
    if constexpr (SP2) {
        PG8_STAGE(PG8_SB(0, 0), cB, voffB); PG8_STAGE(PG8_SB(0, 1), cB + hstep, voffB); PG8_STAGE(PG8_SA(0, 0), cA, voffA); PG8_STAGE(PG8_SA(0, 1), cA + hstep, voffA);
        if (wr == 1) PG8_BAR;
        PG8_WAIT_V(2); PG8_BAR;
        PG8_STAGE(PG8_SB(1, 0), cB + kstep, voffB); PG8_STAGE(PG8_SA(1, 0), cA + kstep, voffA); PG8_STAGE(PG8_SB(1, 1), cB + hstep + kstep, voffB);
        PG8_WAIT_V(6); PG8_BAR;
    } else {
        PG8_STAGE(PG8_SB(0, 0), cB, voffB); PG8_STAGE(PG8_SA(0, 0), cA, voffA); PG8_STAGE(PG8_SB(0, 1), cB + hstep, voffB); PG8_STAGE(PG8_SA(0, 1), cA + hstep, voffA);
        if (wr == 1) PG8_BAR;
        PG8_WAIT_V(4); PG8_BAR;
        PG8_STAGE(PG8_SB(1, 0), cB + kstep, voffB); PG8_STAGE(PG8_SA(1, 0), cA + kstep, voffA); PG8_STAGE(PG8_SB(1, 1), cB + hstep + kstep, voffB);
        PG8_WAIT_V(6); PG8_BAR;
    }
    for (;;) {
        const bool has_next = S.next(ui + 1, nxt);
        const char* nA = has_next ? (const char*)g.A + (size_t)nxt.pm * tstep : cA; const char* nB = has_next ? (const char*)g.Bt + (size_t)nxt.pn * tstep : cB;
        for (int t = 0; t < nt; t += 2) {
            if constexpr (Epi::MIDK) { if (t == E.midk_t) E.midk(acc, cur, wr, fr); }
            const bool last = (t == nt - 2);
            const char* a1 = cA + (size_t)(t + 1) * kstep;
            const char* a2 = last ? nA : cA + (size_t)(t + 2) * kstep; const char* b2 = last ? nB : cB + (size_t)(t + 2) * kstep;
            const char* a3 = a2 + kstep; const char* b3 = b2 + kstep;
            if (last && has_next) S.a_ready(nxt);
            if constexpr (SP2) {
            PG8_LDB(B0, 0, 0); PG8_LDB(B1, 0, 1); PG8_SCHED; PG8_LDA(At, 0, 0); PG8_STAGE(PG8_SA(1, 1), a1 + hstep, voffA);
            PG8_WAIT_V(8); PG8_WAIT_L(0); PG8_BAR; PG8_MMA(0, 0, At, B0); PG8_MMA(0, 1, At, B1); PG8_BAR; PG8_SCHED;
            PG8_LDA(At, 0, 1); PG8_STAGE(PG8_SB(0, 0), b2, voffB); PG8_STAGE(PG8_SB(0, 1), b2 + hstep, voffB); PG8_STAGE(PG8_SA(0, 0), a2, voffA);
            PG8_WAIT_V(8); PG8_WAIT_L(0); PG8_BAR; PG8_MMA(1, 0, At, B0); PG8_MMA(1, 1, At, B1); PG8_BAR; PG8_SCHED;
            PG8_LDB(B0, 1, 0); PG8_LDB(B1, 1, 1); PG8_SCHED; PG8_LDA(At, 1, 0); PG8_STAGE(PG8_SA(0, 1), a2 + hstep, voffA);
            PG8_WAIT_V(8); PG8_WAIT_L(0); PG8_BAR; PG8_MMA(0, 0, At, B0); PG8_MMA(0, 1, At, B1); PG8_BAR; PG8_SCHED;
            PG8_LDA(At, 1, 1); PG8_STAGE(PG8_SB(1, 0), b3, voffB); PG8_STAGE(PG8_SB(1, 1), b3 + hstep, voffB); PG8_STAGE(PG8_SA(1, 0), a3, voffA);
            PG8_WAIT_V(8); PG8_WAIT_L(0); PG8_BAR; PG8_MMA(1, 0, At, B0); PG8_MMA(1, 1, At, B1); PG8_BAR; PG8_SCHED;
            } else {
            PG8_LDB(B0, 0, 0); PG8_SCHED; PG8_LDA(At, 0, 0); PG8_STAGE(PG8_SA(1, 1), a1 + hstep, voffA);
            PG8_WAIT_L(8); PG8_BAR; PG8_WAIT_L(0); PG8_MMA(0, 0, At, B0); PG8_BAR; PG8_SCHED;
            PG8_LDB(B1, 0, 1); PG8_STAGE(PG8_SB(0, 0), b2, voffB);
            PG8_BAR; PG8_WAIT_L(0); PG8_MMA(0, 1, At, B1); PG8_BAR;
            PG8_LDA(At, 0, 1); PG8_STAGE(PG8_SA(0, 0), a2, voffA);
            PG8_BAR; PG8_WAIT_L(0); PG8_MMA(1, 0, At, B0); PG8_BAR; PG8_SCHED;
            PG8_STAGE(PG8_SB(0, 1), b2 + hstep, voffB);
            PG8_WAIT_V(6); PG8_BAR; PG8_MMA(1, 1, At, B1); PG8_BAR;
            PG8_LDB(B0, 1, 0); PG8_SCHED; PG8_LDA(At, 1, 0); PG8_STAGE(PG8_SA(0, 1), a2 + hstep, voffA);
            PG8_WAIT_L(8); PG8_BAR; PG8_WAIT_L(0); PG8_MMA(0, 0, At, B0); PG8_BAR; PG8_SCHED;
            PG8_LDB(B1, 1, 1); PG8_STAGE(PG8_SB(1, 0), b3, voffB);
            PG8_BAR; PG8_WAIT_L(0); PG8_MMA(0, 1, At, B1); PG8_BAR;
            PG8_LDA(At, 1, 1); PG8_STAGE(PG8_SA(1, 0), a3, voffA);
            PG8_BAR; PG8_WAIT_L(0); PG8_MMA(1, 0, At, B0); PG8_BAR; PG8_SCHED;
            PG8_STAGE(PG8_SB(1, 1), b3 + hstep, voffB);
            PG8_WAIT_V(6); PG8_BAR; PG8_MMA(1, 1, At, B1); PG8_BAR;
            }
        }
        if constexpr (ALIGN_EPI) { if (wr == 0) PG8_BAR; }
        if constexpr (!Epi::AFTER_DRAIN) { E(acc, cur, wr, wc, fr, fq); S.done(cur); }
        if (!has_next) break;
#pragma unroll
        for (int a = 0; a < 2; ++a)
#pragma unroll
            for (int b = 0; b < 2; ++b)
#pragma unroll
                for (int m = 0; m < 4; ++m)
#pragma unroll
                    for (int n = 0; n < 2; ++n) acc[a][b][m][n] = (f32x4){0.f, 0.f, 0.f, 0.f};
        cur = nxt; cA = nA; cB = nB; ++ui;
        if constexpr (ALIGN_EPI) { if (wr == 1) PG8_BAR; }
    }
    PG8_WAIT_V(0);
    if constexpr (!ALIGN_EPI) { if (wr == 0) PG8_BAR; }
    PG8_BAR;
    if constexpr (Epi::AFTER_DRAIN) { E.fused(acc, cur, wr, wc, fr, fq, lds, wid, lane); S.done(cur); }
#undef PG8_SA
#undef PG8_SB
#undef PG8_STAGE
#undef PG8_LDA
#undef PG8_LDB
#undef PG8_MMA
#undef PG8_WAIT_V
#undef PG8_WAIT_L
#undef PG8_BAR
#undef PG8_SCHED
}
}
#define XB_TMO      128
#define XB_XCNT(j)  (256  + 64 * (j))
#define XB_XSUB(j)  (1280 + 64 * (j))
#define XB_XGEN(j)  (2304 + 64 * (j))
#define XB_TOP      3328
#define XB_TOPGEN   3392
#define XCD_BAR_WORDS 3456
#define XB_SPIN_CAP (1u << 18)

__device__ __forceinline__ unsigned xb_ld(unsigned* p)              { return __hip_atomic_load(p, __ATOMIC_RELAXED, __HIP_MEMORY_SCOPE_AGENT); }
__device__ __forceinline__ unsigned xb_add(unsigned* p, unsigned v) { return __hip_atomic_fetch_add(p, v, __ATOMIC_RELAXED, __HIP_MEMORY_SCOPE_AGENT); }
__device__ __forceinline__ unsigned xb_xcc_id() { return (unsigned)__builtin_amdgcn_s_getreg((3 << 11) | 20) & 0xFu; }
#define XB_SPIN(cond, bar) do { unsigned _sp = 0; while (cond) { __builtin_amdgcn_s_sleep(1); \
    if ((++_sp & 255u) == 0u) { if (xb_ld(&(bar)[XB_TMO])) break; if (_sp > XB_SPIN_CAP) { atomicAdd(&(bar)[XB_TMO], 1u); break; } } } } while (0)

struct XcdBarrier {
    unsigned* bar; unsigned x;
    volatile LAS unsigned* st;
};

__device__ __forceinline__ XcdBarrier xcd_barrier_post(unsigned* bar, volatile LAS unsigned* st) {
    XcdBarrier b; b.bar = bar; b.x = xb_xcc_id(); b.st = st;
    if (threadIdx.x == 0) (void)xb_add(&bar[XB_XCNT(b.x)], 1u);
    return b;
}
__device__ __forceinline__ void xcd_barrier_complete(unsigned* bar, unsigned x, unsigned& nloc, unsigned& nx) {
    const unsigned G = gridDim.x * gridDim.y * gridDim.z;
    unsigned sum, cnt, mine, sp = 0u;
    for (;;) {
        sum = 0u; cnt = 0u; mine = 0u;
#pragma unroll
        for (unsigned j = 0; j < 16; ++j) { const unsigned c = xb_ld(&bar[XB_XCNT(j)]); sum += c; cnt += (c > 0u) ? 1u : 0u; mine = (j == x) ? c : mine; }
        if (sum == G) break;
        __builtin_amdgcn_s_sleep(1);
        if ((++sp & 255u) == 0u) { if (xb_ld(&bar[XB_TMO])) break; if (sp > XB_SPIN_CAP) { atomicAdd(&bar[XB_TMO], 1u); break; } }
    }
    nloc = mine > 0u ? mine : 1u; nx = cnt > 0u ? cnt : 1u;
}

__device__ __forceinline__ void xcd_barrier(const XcdBarrier& b) {
    asm volatile("s_waitcnt vmcnt(0)" ::: "memory");
    __syncthreads();
    if (threadIdx.x == 0) {
        unsigned* bar = b.bar;
        __builtin_amdgcn_s_waitcnt(0);
        unsigned nloc = b.st[0], nx = b.st[1];
        if (nloc == 0u) { xcd_barrier_complete(bar, b.x, nloc, nx); b.st[0] = nloc; b.st[1] = nx; }
        const unsigned old = xb_add(&bar[XB_XSUB(b.x)], 1u);
        const unsigned gen = old / nloc;
        if (old + 1u == (gen + 1u) * nloc) {
            __builtin_amdgcn_fence(__ATOMIC_RELEASE, "agent");
            asm volatile("s_waitcnt vmcnt(0)" ::: "memory");
            const unsigned og = xb_add(&bar[XB_TOP], 1u);
            const unsigned tg = og / nx;
            if (og + 1u == (tg + 1u) * nx) xb_add(&bar[XB_TOPGEN], 1u);
            else XB_SPIN(xb_ld(&bar[XB_TOPGEN]) == tg, bar);
            __builtin_amdgcn_fence(__ATOMIC_ACQUIRE, "agent");
            xb_add(&bar[XB_XGEN(b.x)], 1u);
            asm volatile("s_waitcnt vmcnt(0)" ::: "memory");
        } else {
            XB_SPIN(xb_ld(&bar[XB_XGEN(b.x)]) == gen, bar);
            __builtin_amdgcn_fence(__ATOMIC_ACQUIRE, "agent");
            asm volatile("s_waitcnt vmcnt(0)" ::: "memory");
        }
    }
    __syncthreads();
}
template <int MAP> __device__ __forceinline__ int map_col(int n) {
    if (MAP == 0) return n;
    if (n < 2304) return n; if (n < 4352) return n + 16; if (n < 5376) return n + 32; if (n < 5392) return n - 5376 + 2304; if (n < 5408) return n - 5392 + 4368; return -1;
}
template <int MAP> __device__ __forceinline__ void transpose_item(const float* W, int K, int Nsrc, int Ndst, const float* kscale, int kscale_n, bf16_t* WT, LAS float* scr, int item, int lane) {
    const int nblk = Ndst / 32, kb = item / nblk, nb = item % nblk, k0 = 64 * kb, n0 = 32 * nb;
    const int sc = map_col<MAP>(n0 + (lane & 31));
#pragma unroll 8
    for (int i = 0; i < 32; ++i) { const int kk = 2 * i + (lane >> 5); float v = sc >= 0 ? W[(size_t)(k0 + kk) * Nsrc + sc] : 0.f; if (kscale && (k0 + kk) < kscale_n) v *= kscale[k0 + kk]; scr[kk * 33 + (lane & 31)] = v; }
    asm volatile("s_waitcnt lgkmcnt(0)" ::: "memory");
    const int c = lane & 7;
#pragma unroll
    for (int j = 0; j < 4; ++j) { const int n = (lane >> 3) + 8 * j; const LAS float* s = scr + (8 * c) * 33 + n;
        v4u o; o.x = pk2(s[0 * 33], s[1 * 33]); o.y = pk2(s[2 * 33], s[3 * 33]); o.z = pk2(s[4 * 33], s[5 * 33]); o.w = pk2(s[6 * 33], s[7 * 33]);
        *(v4u*)(WT + (size_t)(n0 + n) * K + k0 + 8 * c) = o; }
    asm volatile("s_waitcnt lgkmcnt(0)" ::: "memory");
}
__device__ __forceinline__ void rms_row_to_bf16(const float* xrow, const float* w, bf16_t* orow, int lane) {
    const v4f* xr = (const v4f*)xrow + lane; const v4f* wr = (const v4f*)w + lane;
    v4f v[4]; float s = 0.f;
#pragma unroll
    for (int j = 0; j < 4; ++j) { v[j] = xr[64 * j]; s += (v[j].x * v[j].x + v[j].y * v[j].y) + (v[j].z * v[j].z + v[j].w * v[j].w); }
    const float rstd = 1.0f / sqrtf(wave_sum(s) * (1.f / 1024.f) + RMS_EPS);
    unsigned long long* o8 = (unsigned long long*)orow + lane;
#pragma unroll
    for (int j = 0; j < 4; ++j) { const v4f ww = wr[64 * j]; o8[64 * j] = (unsigned long long)pk2(v[j].x * rstd * ww.x, v[j].y * rstd * ww.y) | ((unsigned long long)pk2(v[j].z * rstd * ww.z, v[j].w * rstd * ww.w) << 32); }
}
__device__ __forceinline__ void rms_row_f32(const float* xrow, const float* w, float* orow, int lane) {
    const v4f* xr = (const v4f*)xrow + lane; const v4f* wr = (const v4f*)w + lane;
    v4f v[4]; float s = 0.f;
#pragma unroll
    for (int j = 0; j < 4; ++j) { v[j] = xr[64 * j]; s += (v[j].x * v[j].x + v[j].y * v[j].y) + (v[j].z * v[j].z + v[j].w * v[j].w); }
    const float rstd = 1.0f / sqrtf(wave_sum(s) * (1.f / 1024.f) + RMS_EPS);
    v4f* o = (v4f*)orow + lane;
#pragma unroll
    for (int j = 0; j < 4; ++j) o[64 * j] = v[j] * rstd * wr[64 * j];
}

struct Params {
    const float *x, *even_norm, *even_w_in, *conv_w, *conv_b, *a_log, *dt_bias, *d_skip, *ssd_norm, *gate_w2, *gate_b, *gla_norm, *even_w_out, *odd_norm, *odd_w_in, *odd_w_out, *final_norm;
    float* out; unsigned char* ws;
};
__device__ __forceinline__ void p0_phase(const Params& P, LAS unsigned char* lds, int gw, int NGW, int lane, int wave) {
    LAS float* scr = (LAS float*)lds + wave * 64 * 33;
    constexpr int I_A = (1024 / 64) * (N0 / 32), I_B = (2048 / 64) * (1024 / 32);
    for (int it = gw; it < I_A + I_B; it += NGW) {
        if (it < I_A) transpose_item<1>(P.even_w_in, 1024, 5408, N0, nullptr, 0, (bf16_t*)(P.ws + WS_BT0), scr, it, lane);
        else transpose_item<0>(P.even_w_out, 2048, 1024, 1024, P.ssd_norm, 1024, (bf16_t*)(P.ws + WS_BT1), scr, it - I_A, lane);
    }
    for (int m = gw; m < MTOK; m += NGW) rms_row_to_bf16(P.x + (size_t)m * 1024, P.even_norm, (bf16_t*)P.out + (size_t)m * 1024, lane);
}
__device__ __forceinline__ void p3b_phase(const Params& P, LAS unsigned char* lds, int gw, int NGW, int lane, int wave) {
    LAS float* scr = (LAS float*)lds + wave * 64 * 33;
    constexpr int I_A = (1024 / 64) * (4096 / 32), I_B = (1024 / 64) * (1024 / 32);
    for (int it = gw; it < I_A + I_B; it += NGW) {
        if (it < I_A) transpose_item<0>(P.odd_w_in, 1024, 4096, 4096, nullptr, 0, (bf16_t*)(P.ws + WS_BT2), scr, it, lane);
        else transpose_item<0>(P.odd_w_out, 1024, 1024, 1024, nullptr, 0, (bf16_t*)(P.ws + WS_BT3), scr, it - I_A, lane);
    }
    for (int m = gw; m < MTOK; m += NGW) rms_row_to_bf16(P.out + (size_t)m * 1024, P.odd_norm, (bf16_t*)(P.ws + WS_YG) + (size_t)m * 1024, lane);
}
namespace moba {
typedef short bf16x8 __attribute__((ext_vector_type(8)));
typedef short s16x4 __attribute__((ext_vector_type(4)));
typedef float f32x16 __attribute__((ext_vector_type(16)));
typedef float f32x2_t __attribute__((ext_vector_type(2)));
typedef __bf16 bf16x2_t __attribute__((ext_vector_type(2)));
typedef short v4i16_t __attribute__((ext_vector_type(4)));
typedef const LAS char* lds_cptr;
__device__ __forceinline__ int crow(int r, int hi) { return (r & 3) + 8 * (r >> 2) + 4 * hi; }
__device__ __forceinline__ unsigned cvtpk(float lo, float hi) { f32x2_t v = {lo, hi}; bf16x2_t b = __builtin_convertvector(v, bf16x2_t); return __builtin_bit_cast(unsigned, b); }
__device__ __forceinline__ s16x4 vtr(lds_cptr p) { return __builtin_bit_cast(s16x4, __builtin_amdgcn_ds_read_tr16_b64_v4i16((LAS v4i16_t*)p)); }
constexpr int L_K = 0, L_V = 16384, L_KS = 32768, L_BYTES = 32768 + 2048;

__device__ __forceinline__ void unit(const Params& P, int b, int h, int nb, LAS unsigned char* lds) {
    int tid_ = threadIdx.x; asm volatile("" : "+v"(tid_));
    const int tid = tid_, lane = tid & 63, r32 = lane & 31, hi = lane >> 5, wid = __builtin_amdgcn_readfirstlane(tid >> 6);
    const bf16_t* U1 = (const bf16_t*)(P.ws + WS_U);
    const size_t rowbase = (size_t)b * SEQ; const int q0 = nb * 256;
    { const float* ksum = (const float*)(P.ws + WS_CTL + CTL_KSUM); LAS float* sk = (LAS float*)(lds + L_KS);
      sk[tid] = ksum[(size_t)(b * 8 + (tid >> 6)) * 1024 + h * 64 + (tid & 63)]; }
    const bf16_t* ksrc0 = U1 + (rowbase + lane) * U1P + 1024 + h * 64 + wid * 8;
    const bf16_t* vsrc0 = U1 + (rowbase + 16 * (wid & 3) + (lane >> 2)) * U1P + 2048 + h * 64 + (wid >> 2) * 32 + (lane & 3) * 8;
    const int stoff = wid * 1024 + lane * 16;
    const int NT = 4 * (nb + 1);
#define MOBA_TILE_ROW(s) (((s) < 4) ? (q0 + (s) * 64) : ((((s) - 4) >> 2) * 256 + (((s) - 4) & 3) * 64))
    v4u kreg[3], vreg[3];
#define MOBA_LOAD(SL, s_) do { const size_t ro_ = (size_t)MOBA_TILE_ROW(s_) * U1P; kreg[SL] = *(const v4u*)(ksrc0 + ro_); vreg[SL] = *(const v4u*)(vsrc0 + ro_); } while (0)
#define MOBA_WRITE(SL, s_) do { *(LAS v4u*)(lds + L_K + ((s_) & 1) * 8192 + stoff) = kreg[SL]; *(LAS v4u*)(lds + L_V + ((s_) & 1) * 8192 + stoff) = vreg[SL]; } while (0)
    MOBA_LOAD(0, 0); MOBA_LOAD(1, 1); MOBA_LOAD(2, 2);
    const bf16_t* Qw = U1 + (rowbase + q0 + wid * 32 + r32) * U1P + h * 64;
    bf16x8 qr[4];
#pragma unroll
    for (int d0 = 0; d0 < 4; ++d0) qr[d0] = *(const bf16x8*)(Qw + d0 * 16 + hi * 8);
    MOBA_WRITE(0, 0);
    __syncthreads();
    unsigned sel = 0;
    if (nb > 0) {
        const LAS float* sk = (const LAS float*)(lds + L_KS);
        float gate[8];
#pragma unroll
        for (int j = 0; j < 7; ++j) { float s = 0.f;
            if (j < nb) {
#pragma unroll
                for (int d0 = 0; d0 < 4; ++d0)
#pragma unroll
                    for (int e = 0; e < 8; ++e) s += bf2f((unsigned short)qr[d0][e]) * sk[j * 64 + d0 * 16 + hi * 8 + e];
                s += __shfl_xor(s, 32); }
            gate[j] = s; }
        gate[7] = 0.f;
#pragma unroll
        for (int j = 0; j < 7; ++j) { if (j < nb) { int rank = 0;
#pragma unroll
                for (int i = 0; i < 7; ++i) if (i < nb && (gate[i] > gate[j] || (gate[i] == gate[j] && i < j))) ++rank;
                if (rank < 3) sel |= 1u << j; } }
    }
    float mref = 0.f, l = 0.f; f32x16 o0 = {}, o1 = {};
    const int qloc = wid * 32 + r32;
    const lds_cptr vp0 = (lds_cptr)lds + L_V + ((lane >> 4) & 1) * 32 + (lane & 3) * 8 + (4 * hi + ((lane & 15) >> 2)) * 64;
    const lds_cptr kp0 = (lds_cptr)lds + L_K + hi * 1024 + r32 * 16;
#define MOBA_STEP(SL) do { \
        MOBA_LOAD(SL, (s + 3 < NT ? s + 3 : NT - 1));        \
        moba_compute_tile(); \
        MOBA_WRITE(((SL) + 1) % 3, s + 1);                     \
        __syncthreads(); ++s; } while (0)
    int s = 0;
    auto moba_compute_tile = [&]() __attribute__((always_inline)) {
        const bool own = s < 4; const int kt = own ? s : ((s - 4) & 3); const int jb = own ? nb : ((s - 4) >> 2);
        const bool lane_on = own || ((sel >> jb) & 1u);
        const bool active = own ? (kt * 64 <= wid * 32 + 31) : (__any(lane_on) != 0);
        if (active) {
            const lds_cptr kp = kp0 + (s & 1) * 8192; const lds_cptr vp = vp0 + (s & 1) * 8192;
            const float cin = lane_on ? -mref : -INFINITY;
            f32x16 p0, p1;
#pragma unroll
            for (int r = 0; r < 16; ++r) { p0[r] = cin; p1[r] = cin; }
#pragma unroll
            for (int d0 = 0; d0 < 4; ++d0) {
                const bf16x8 k0 = *(const LAS bf16x8*)(kp + d0 * 2048), k1 = *(const LAS bf16x8*)(kp + d0 * 2048 + 512);
                p0 = __builtin_amdgcn_mfma_f32_32x32x16_bf16(k0, qr[d0], p0, 0, 0, 0);
                p1 = __builtin_amdgcn_mfma_f32_32x32x16_bf16(k1, qr[d0], p1, 0, 0, 0); }
            if (own && kt == (wid >> 1)) {
#pragma unroll
                for (int r = 0; r < 16; ++r) { const int key = kt * 64 + crow(r, hi); if (key > qloc) p0[r] = -INFINITY; if (key + 32 > qloc) p1[r] = -INFINITY; }
            }
            float ra = fmaxf(fmaxf(p0[0], p0[1]), p1[0]), rb = fmaxf(fmaxf(p0[2], p0[3]), p1[1]); ra = fmaxf(fmaxf(ra, p1[2]), p1[3]);
#pragma unroll
            for (int r = 4; r < 16; r += 4) { ra = fmaxf(fmaxf(ra, p0[r]), p0[r + 1]); rb = fmaxf(fmaxf(rb, p0[r + 2]), p0[r + 3]); ra = fmaxf(fmaxf(ra, p1[r]), p1[r + 1]); rb = fmaxf(fmaxf(rb, p1[r + 2]), p1[r + 3]); }
            float rm = fmaxf(ra, rb);
            { auto rr = __builtin_amdgcn_permlane32_swap(__float_as_uint(rm), __float_as_uint(rm), false, false); rm = fmaxf(__uint_as_float(rr[0]), __uint_as_float(rr[1])); }
            if (__builtin_expect(s == 0 || __any(rm > 8.0f), 0)) {
                const float dl = (s == 0) ? rm : fmaxf(rm, 0.f);
                mref += dl;
                const float f = __builtin_amdgcn_exp2f(-dl);
                l *= f;
#pragma unroll
                for (int r = 0; r < 16; ++r) { p0[r] -= dl; p1[r] -= dl; o0[r] *= f; o1[r] *= f; }
            }
            float rs0 = 0.f, rs1 = 0.f;
#pragma unroll
            for (int r = 0; r < 16; ++r) { p0[r] = __builtin_amdgcn_exp2f(p0[r]); p1[r] = __builtin_amdgcn_exp2f(p1[r]); rs0 += p0[r]; rs1 += p1[r]; }
            l += rs0 + rs1;
            v4u pw[4];
#pragma unroll
            for (int e = 0; e < 4; ++e) { pw[0][e] = cvtpk(p0[2 * e], p0[2 * e + 1]); pw[1][e] = cvtpk(p0[8 + 2 * e], p0[8 + 2 * e + 1]); pw[2][e] = cvtpk(p1[2 * e], p1[2 * e + 1]); pw[3][e] = cvtpk(p1[8 + 2 * e], p1[8 + 2 * e + 1]); }
#pragma unroll
            for (int ks = 0; ks < 4; ++ks) {
                const s16x4 a0 = vtr(vp + ks * 1024), a1 = vtr(vp + ks * 1024 + 512), c0 = vtr(vp + 4096 + ks * 1024), c1 = vtr(vp + 4096 + ks * 1024 + 512);
                const bf16x8 v0 = (bf16x8){a0[0], a0[1], a0[2], a0[3], a1[0], a1[1], a1[2], a1[3]}, v1 = (bf16x8){c0[0], c0[1], c0[2], c0[3], c1[0], c1[1], c1[2], c1[3]};
                const bf16x8 pf = __builtin_bit_cast(bf16x8, pw[ks]);
                o0 = __builtin_amdgcn_mfma_f32_32x32x16_bf16(v0, pf, o0, 0, 0, 0);
                o1 = __builtin_amdgcn_mfma_f32_32x32x16_bf16(v1, pf, o1, 0, 0, 0); }
        }
    };
    while (s < NT) { MOBA_STEP(0); if (s >= NT) break; MOBA_STEP(1); if (s >= NT) break; MOBA_STEP(2); }
#undef MOBA_STEP
#undef MOBA_LOAD
#undef MOBA_WRITE
#undef MOBA_TILE_ROW
    { auto rr = __builtin_amdgcn_permlane32_swap(__float_as_uint(l), __float_as_uint(l), false, false); l = __uint_as_float(rr[0]) + __uint_as_float(rr[1]); }
    const float inv = 1.0f / l;
    const size_t row = rowbase + q0 + wid * 32 + r32;
    const bf16_t* zp = U1 + row * U1P + 3072 + h * 64; bf16_t* op = (bf16_t*)(P.ws + WS_YG + 32 * MiB) + row * 1024 + h * 64;
#pragma unroll
    for (int g = 0; g < 4; ++g) {
        const int d = 8 * g + 4 * hi;
        const v2u z0 = *(const v2u*)(zp + d), z1 = *(const v2u*)(zp + 32 + d);
        v2u w0, w1;
        w0.x = cvtpk(o0[4 * g] * inv * bf2f(z0.x & 0xffffu), o0[4 * g + 1] * inv * bf2f(z0.x >> 16)); w0.y = cvtpk(o0[4 * g + 2] * inv * bf2f(z0.y & 0xffffu), o0[4 * g + 3] * inv * bf2f(z0.y >> 16));
        w1.x = cvtpk(o1[4 * g] * inv * bf2f(z1.x & 0xffffu), o1[4 * g + 1] * inv * bf2f(z1.x >> 16)); w1.y = cvtpk(o1[4 * g + 2] * inv * bf2f(z1.y & 0xffffu), o1[4 * g + 3] * inv * bf2f(z1.y >> 16));
        *(v2u*)(op + d) = w0; *(v2u*)(op + 32 + d) = w1;
    }
    __syncthreads();
}
__device__ __forceinline__ void phase(const Params& P, LAS unsigned char* lds, int G, int bx) {
    if (G == 256) {
        const int vcu = (bx % 8) * (G / 8) + bx / 8, bh = vcu >> 1, odd = vcu & 1;
        for (int i = 0; i < 4; ++i) { const int nb = odd ? ((i == 0) ? 6 : (i == 1) ? 1 : (i == 2) ? 4 : 3) : ((i == 0) ? 7 : (i == 1) ? 0 : (i == 2) ? 5 : 2);
            unit(P, bh >> 4, bh & 15, nb, lds); }
    } else {
        for (int u = bx; u < BATCH * 16 * 8; u += G) unit(P, u / 128, (u / 8) % 16, u % 8, lds);
    }
}
}
namespace mix {
using moba::bf16x8; using moba::s16x4; using moba::f32x16; using moba::lds_cptr; using moba::cvtpk; using moba::vtr;
constexpr float LOG2E = 1.4426950408889634f;
__device__ __forceinline__ bf16x8 trfrag(lds_cptr p) { const s16x4 a = vtr(p), c = vtr(p + 512); return (bf16x8){a[0], a[1], a[2], a[3], c[0], c[1], c[2], c[3]}; }
__device__ __forceinline__ v4u pack8(const float* v) { v4u o; o.x = cvtpk(v[0], v[1]); o.y = cvtpk(v[2], v[3]); o.z = cvtpk(v[4], v[5]); o.w = cvtpk(v[6], v[7]); return o; }
__device__ __forceinline__ float silu_fast(float x) { return x * __builtin_amdgcn_rcpf(1.f + __builtin_amdgcn_exp2f(-LOG2E * x)); }

constexpr int S_X = 0, S_BM = 16384, S_BW = 32768, S_CM = 49152, S_SB = 65536, S_ACS = 73728, S_DT = S_ACS + 512, S_E = S_DT + 512, S_W = S_E + 512, S_AL = S_W + 512, S_CW = S_AL + 16, S_END = S_CW + 3840;
__device__ __forceinline__ void ssd_unit(const Params& P, int b, int hd, LAS unsigned char* lds, size_t ssq_off) {
    int tid_ = threadIdx.x; asm volatile("" : "+v"(tid_));
    const int tid = tid_, lane = tid & 63, r32 = lane & 31, hi = lane >> 5, wid = __builtin_amdgcn_readfirstlane(tid >> 6);
    const int g = hd >> 3, it = wid >> 1, pt = wid & 1;
    const bf16_t* U0 = (const bf16_t*)(P.ws + WS_U); const float* SM = (const float*)(P.ws + WS_SM);
    bf16_t* YG = (bf16_t*)(P.ws + WS_YG); float* ssq = (float*)(P.ws + WS_CTL + ssq_off);
    const float a = -__expf(P.a_log[hd]), dtb = P.dt_bias[hd], Dk = P.d_skip[hd];
    const size_t rowbase = (size_t)b * SEQ;
    LAS float* cw = (LAS float*)(lds + S_CW);
    for (int i = tid; i < 960; i += 512) { const int k = i / 192, cc = i % 192; const int ch = cc < 64 ? hd * 64 + cc : (cc < 128 ? 1024 + g * 64 + cc - 64 : 1152 + g * 64 + cc - 128); cw[i] = k < 4 ? P.conv_w[k * 1280 + ch] : P.conv_b[ch]; }
    for (int i = tid; i < 8192 / 16; i += 512) *(LAS v4u*)(lds + S_SB + i * 16) = (v4u){0u, 0u, 0u, 0u};
    LAS float* acsL = (LAS float*)(lds + S_ACS); LAS float* dtL = (LAS float*)(lds + S_DT); LAS float* eL = (LAS float*)(lds + S_E); LAS float* wL = (LAS float*)(lds + S_W); LAS float* alL = (LAS float*)(lds + S_AL);
    const int vlane = ((lane >> 4) & 1) * 32 + (lane & 3) * 8 + (4 * hi + ((lane & 15) >> 2)) * 64;
    const lds_cptr Xl = (lds_cptr)lds + S_X + vlane, Bwl = (lds_cptr)lds + S_BW + vlane;
    const int icol = 32 * it + r32, prow = 32 * pt + r32;
    f32x16 S = {};
    for (int c = 0; c < 16; ++c) {
        const int t0 = c * 128;
        if (wid == 0) {
            const float d0 = softplus_f(SM[(rowbase + t0 + 2 * lane) * 32 + hd] + dtb), d1 = softplus_f(SM[(rowbase + t0 + 2 * lane + 1) * 32 + hd] + dtb);
            const float v0 = d0 * a, v1 = d1 * a;
            float inc = v0 + v1;
#pragma unroll
            for (int o = 1; o < 64; o <<= 1) { const float t = __shfl_up(inc, o); if (lane >= o) inc += t; }
            const float al = __shfl(inc, 63), c1 = inc, c0 = inc - v1;
            acsL[2 * lane] = c0; acsL[2 * lane + 1] = c1; dtL[2 * lane] = d0; dtL[2 * lane + 1] = d1;
            eL[2 * lane] = __expf(c0); eL[2 * lane + 1] = __expf(c1); wL[2 * lane] = __expf(al - c0) * d0; wL[2 * lane + 1] = __expf(al - c1) * d1;
            if (lane == 0) alL[0] = al;
        }
        __syncthreads();
#pragma unroll 2
        for (int k = 0; k < 6; ++k) {
            const int item = tid + 512 * k, c8 = item % 24, t = item / 24;
            const int kind = c8 >> 3, cc = c8 * 8;
            const int ch = kind == 0 ? hd * 64 + cc : (kind == 1 ? 1024 + g * 64 + cc - 64 : 1152 + g * 64 + cc - 128);
            const bf16_t* up = U0 + (rowbase + t0 + t) * U0P + COL_XBC + ch;
            float acc[8];
            { const v4f b0 = *(const LAS v4f*)(cw + 4 * 192 + cc), b1 = *(const LAS v4f*)(cw + 4 * 192 + cc + 4); acc[0] = b0.x; acc[1] = b0.y; acc[2] = b0.z; acc[3] = b0.w; acc[4] = b1.x; acc[5] = b1.y; acc[6] = b1.z; acc[7] = b1.w; }
#pragma unroll
            for (int kk = 0; kk < 4; ++kk) {
                v4u u = (v4u){0u, 0u, 0u, 0u};
                if (t0 + t - 3 + kk >= 0) u = *(const v4u*)(up - (ptrdiff_t)(3 - kk) * U0P);
                const v4f w0 = *(const LAS v4f*)(cw + kk * 192 + cc), w1 = *(const LAS v4f*)(cw + kk * 192 + cc + 4);
                acc[0] += w0.x * bf2f(u.x & 0xffffu); acc[1] += w0.y * bf2f(u.x >> 16); acc[2] += w0.z * bf2f(u.y & 0xffffu); acc[3] += w0.w * bf2f(u.y >> 16);
                acc[4] += w1.x * bf2f(u.z & 0xffffu); acc[5] += w1.y * bf2f(u.z >> 16); acc[6] += w1.z * bf2f(u.w & 0xffffu); acc[7] += w1.w * bf2f(u.w >> 16);
            }
#pragma unroll
            for (int e = 0; e < 8; ++e) acc[e] = silu_fast(acc[e]);
            const int c8l = c8 & 7;
            const int voff = ((c8l >> 2) * 8 + (t >> 4)) * 1024 + (t & 15) * 64 + (c8l & 3) * 16, koff = c8l * 2048 + t * 16;
            if (kind == 0) *(LAS v4u*)(lds + S_X + voff) = pack8(acc);
            else if (kind == 2) *(LAS v4u*)(lds + S_CM + koff) = pack8(acc);
            else { *(LAS v4u*)(lds + S_BM + koff) = pack8(acc); const float w = wL[t];
#pragma unroll
                for (int e = 0; e < 8; ++e) acc[e] *= w;
                *(LAS v4u*)(lds + S_BW + voff) = pack8(acc); }
        }
        __syncthreads();
        {
            bf16x8 cf[4];
#pragma unroll
            for (int d0 = 0; d0 < 4; ++d0) cf[d0] = *(const LAS bf16x8*)(lds + S_CM + (2 * d0 + hi) * 2048 + icol * 16);
            f32x16 Y = {};
#pragma unroll
            for (int d0 = 0; d0 < 4; ++d0) { const bf16x8 sf = *(const LAS bf16x8*)(lds + S_SB + (2 * d0 + hi) * 1024 + prow * 16); Y = __builtin_amdgcn_mfma_f32_32x32x16_bf16(sf, cf[d0], Y, 0, 0, 0); }
            const float acs_i = acsL[icol], e_i = eL[icol];
#pragma unroll
            for (int r = 0; r < 16; ++r) Y[r] *= e_i;
            for (int jt = 0; jt <= it; ++jt) {
                f32x16 cb = {};
#pragma unroll
                for (int d0 = 0; d0 < 4; ++d0) { const bf16x8 bf = *(const LAS bf16x8*)(lds + S_BM + (2 * d0 + hi) * 2048 + (32 * jt + r32) * 16); cb = __builtin_amdgcn_mfma_f32_32x32x16_bf16(bf, cf[d0], cb, 0, 0, 0); }
                const bool diag = (jt == it);
#pragma unroll
                for (int q = 0; q < 4; ++q) {
                    const v4f aj = *(const LAS v4f*)(acsL + 32 * jt + 8 * q + 4 * hi), dj = *(const LAS v4f*)(dtL + 32 * jt + 8 * q + 4 * hi);
#pragma unroll
                    for (int e = 0; e < 4; ++e) { const float mv = cb[4 * q + e] * __builtin_amdgcn_exp2f((acs_i - aj[e]) * LOG2E) * dj[e]; cb[4 * q + e] = (diag && (8 * q + 4 * hi + e) > r32) ? 0.f : mv; }
                }
                v4u pw0, pw1;
#pragma unroll
                for (int e = 0; e < 4; ++e) { pw0[e] = cvtpk(cb[2 * e], cb[2 * e + 1]); pw1[e] = cvtpk(cb[8 + 2 * e], cb[8 + 2 * e + 1]); }
                const bf16x8 x0 = trfrag(Xl + pt * 8192 + (2 * jt) * 1024), x1 = trfrag(Xl + pt * 8192 + (2 * jt + 1) * 1024);
                Y = __builtin_amdgcn_mfma_f32_32x32x16_bf16(x0, __builtin_bit_cast(bf16x8, pw0), Y, 0, 0, 0);
                Y = __builtin_amdgcn_mfma_f32_32x32x16_bf16(x1, __builtin_bit_cast(bf16x8, pw1), Y, 0, 0, 0);
            }
            const size_t row = rowbase + t0 + icol;
            float ssum = 0.f;
#pragma unroll
            for (int q = 0; q < 4; ++q) {
                const int pc = 8 * q + 4 * hi;
                const v2u xx = *(const LAS v2u*)(lds + S_X + (pt * 8 + (icol >> 4)) * 1024 + (icol & 15) * 64 + pc * 2);
                const v2u zz = *(const v2u*)(U0 + row * U0P + COL_Z + hd * 64 + 32 * pt + pc);
                const float y0 = (Y[4 * q] + Dk * bf2f(xx.x & 0xffffu)) * silu_fast(bf2f(zz.x & 0xffffu)), y1 = (Y[4 * q + 1] + Dk * bf2f(xx.x >> 16)) * silu_fast(bf2f(zz.x >> 16));
                const float y2 = (Y[4 * q + 2] + Dk * bf2f(xx.y & 0xffffu)) * silu_fast(bf2f(zz.y & 0xffffu)), y3 = (Y[4 * q + 3] + Dk * bf2f(xx.y >> 16)) * silu_fast(bf2f(zz.y >> 16));
                ssum += (y0 * y0 + y1 * y1) + (y2 * y2 + y3 * y3);
                v2u w; w.x = cvtpk(y0, y1); w.y = cvtpk(y2, y3);
                *(v2u*)(YG + row * 2048 + hd * 64 + 32 * pt + pc) = w;
            }
            ssum += __shfl_xor(ssum, 32);
            if (hi == 0) atomicAdd(&ssq[row], ssum);
        }
        if (wid < 4) {
            const float dA = __expf(alL[0]);
#pragma unroll
            for (int r = 0; r < 16; ++r) S[r] *= dA;
#pragma unroll
            for (int ks = 0; ks < 8; ++ks) { const bf16x8 af = trfrag(Bwl + it * 8192 + ks * 1024), xf = trfrag(Xl + pt * 8192 + ks * 1024); S = __builtin_amdgcn_mfma_f32_32x32x16_bf16(af, xf, S, 0, 0, 0); }
        }
        __syncthreads();
        if (wid < 4) {
#pragma unroll
            for (int q = 0; q < 4; ++q) { v2u w; w.x = cvtpk(S[4 * q], S[4 * q + 1]); w.y = cvtpk(S[4 * q + 2], S[4 * q + 3]); *(LAS v2u*)(lds + S_SB + (4 * it + q) * 1024 + prow * 16 + hi * 8) = w; }
        }
    }
    __syncthreads();
}

constexpr int G_QT = 0, G_KT = 8192, G_QG = 16384, G_KW = 24576, G_V = 32768, G_ST = 49152, G_GCS = 65536, G_TOT = 81920, G_REF = G_TOT + 2048, G_GL = G_REF + 256, G_EGL = G_GL + 256, G_SS = G_EGL + 256, G_END = G_SS + 1024;
__device__ __forceinline__ void gla_unit(const Params& P, int b, int h, LAS unsigned char* lds) {
    int tid_ = threadIdx.x; asm volatile("" : "+v"(tid_));
    const int tid = tid_, lane = tid & 63, r32 = lane & 31, hi = lane >> 5, wid = __builtin_amdgcn_readfirstlane(tid >> 6);
    const int vt = wid >> 1, it = wid & 1;
    const bf16_t* U0 = (const bf16_t*)(P.ws + WS_U); const float* SM = (const float*)(P.ws + WS_SM);
    bf16_t* YG = (bf16_t*)(P.ws + WS_YG);
    const size_t rowbase = (size_t)b * SEQ;
    float w2[16];
#pragma unroll
    for (int r = 0; r < 16; ++r) w2[r] = P.gate_w2[r * 512 + h * 64 + lane];
    const float gb = P.gate_b[h * 64 + lane];
    for (int i = tid; i < 16384 / 16; i += 512) *(LAS v4u*)(lds + G_ST + i * 16) = (v4u){0u, 0u, 0u, 0u};
    LAS float* gcsL = (LAS float*)(lds + G_GCS); LAS float* totL = (LAS float*)(lds + G_TOT); LAS float* refL = (LAS float*)(lds + G_REF); LAS float* glL = (LAS float*)(lds + G_GL); LAS float* eglL = (LAS float*)(lds + G_EGL); LAS float* ssL = (LAS float*)(lds + G_SS);
    const int vlane = ((lane >> 4) & 1) * 32 + (lane & 3) * 8 + (4 * hi + ((lane & 15) >> 2)) * 64;
    const lds_cptr Vl = (lds_cptr)lds + G_V + vlane, KWl = (lds_cptr)lds + G_KW + vlane;
    const int icol = 32 * it + r32, vrow = 32 * vt + r32;
    f32x16 S = {};
    for (int c = 0; c < 32; ++c) {
        const int t0 = c * 64;
        float loc[8];
        {
            float run = 0.f;
#pragma unroll
            for (int tt = 0; tt < 8; ++tt) {
                const float* gl = SM + (rowbase + t0 + 8 * wid + tt) * 32 + 16;
                float pre = gb;
#pragma unroll
                for (int r = 0; r < 16; ++r) pre += gl[r] * w2[r];
                run += logsigmoid_f(pre) * (1.0f / 16.0f);
                loc[tt] = run;
            }
            totL[wid * 64 + lane] = run;
        }
        __syncthreads();
        {
            float off = 0.f, ref = 0.f, gl = 0.f;
#pragma unroll
            for (int w = 0; w < 8; ++w) { const float t = totL[w * 64 + lane]; if (w < wid) off += t; if (w < 4) ref += t; gl += t; }
#pragma unroll
            for (int tt = 0; tt < 8; ++tt) gcsL[(8 * wid + tt) * 64 + lane] = off + loc[tt];
            if (wid == 0) { refL[lane] = ref; glL[lane] = gl; eglL[lane] = __expf(gl); }
        }
        __syncthreads();
        {
            const int t = tid >> 3, c8 = tid & 7;
            const bf16_t* ur = U0 + (rowbase + t0 + t) * U0P;
            const v4u qv = *(const v4u*)(ur + COL_Q + h * 64 + c8 * 8), kv = *(const v4u*)(ur + COL_K + h * 64 + c8 * 8);
            float gc[8], rf[8], gl[8], q[8], k[8], o[8];
            { const v4f a0 = *(const LAS v4f*)(gcsL + t * 64 + c8 * 8), a1 = *(const LAS v4f*)(gcsL + t * 64 + c8 * 8 + 4); gc[0] = a0.x; gc[1] = a0.y; gc[2] = a0.z; gc[3] = a0.w; gc[4] = a1.x; gc[5] = a1.y; gc[6] = a1.z; gc[7] = a1.w; }
            { const v4f a0 = *(const LAS v4f*)(refL + c8 * 8), a1 = *(const LAS v4f*)(refL + c8 * 8 + 4); rf[0] = a0.x; rf[1] = a0.y; rf[2] = a0.z; rf[3] = a0.w; rf[4] = a1.x; rf[5] = a1.y; rf[6] = a1.z; rf[7] = a1.w; }
            { const v4f a0 = *(const LAS v4f*)(glL + c8 * 8), a1 = *(const LAS v4f*)(glL + c8 * 8 + 4); gl[0] = a0.x; gl[1] = a0.y; gl[2] = a0.z; gl[3] = a0.w; gl[4] = a1.x; gl[5] = a1.y; gl[6] = a1.z; gl[7] = a1.w; }
            q[0] = bf2f(qv.x & 0xffffu); q[1] = bf2f(qv.x >> 16); q[2] = bf2f(qv.y & 0xffffu); q[3] = bf2f(qv.y >> 16); q[4] = bf2f(qv.z & 0xffffu); q[5] = bf2f(qv.z >> 16); q[6] = bf2f(qv.w & 0xffffu); q[7] = bf2f(qv.w >> 16);
            k[0] = bf2f(kv.x & 0xffffu); k[1] = bf2f(kv.x >> 16); k[2] = bf2f(kv.y & 0xffffu); k[3] = bf2f(kv.y >> 16); k[4] = bf2f(kv.z & 0xffffu); k[5] = bf2f(kv.z >> 16); k[6] = bf2f(kv.w & 0xffffu); k[7] = bf2f(kv.w >> 16);
            const int koff = c8 * 1024 + t * 16, voff = ((c8 >> 2) * 4 + (t >> 4)) * 1024 + (t & 15) * 64 + (c8 & 3) * 16;
#pragma unroll
            for (int e = 0; e < 8; ++e) o[e] = q[e] * 0.125f * __builtin_amdgcn_exp2f((gc[e] - rf[e]) * LOG2E);
            *(LAS v4u*)(lds + G_QT + koff) = pack8(o);
#pragma unroll
            for (int e = 0; e < 8; ++e) o[e] = k[e] * __builtin_amdgcn_exp2f((rf[e] - gc[e]) * LOG2E);
            *(LAS v4u*)(lds + G_KT + koff) = pack8(o);
#pragma unroll
            for (int e = 0; e < 8; ++e) o[e] = q[e] * 0.125f * __builtin_amdgcn_exp2f(gc[e] * LOG2E);
            *(LAS v4u*)(lds + G_QG + koff) = pack8(o);
#pragma unroll
            for (int e = 0; e < 8; ++e) o[e] = k[e] * __builtin_amdgcn_exp2f((gl[e] - gc[e]) * LOG2E);
            *(LAS v4u*)(lds + G_KW + voff) = pack8(o);
#pragma unroll
            for (int kk = 0; kk < 2; ++kk) { const int item = tid + 512 * kk, tv = item >> 4, cv = item & 15;
                const v4u vv = *(const v4u*)(U0 + (rowbase + t0 + tv) * U0P + COL_V + h * 128 + cv * 8);
                *(LAS v4u*)(lds + G_V + ((cv >> 2) * 4 + (tv >> 4)) * 1024 + (tv & 15) * 64 + (cv & 3) * 16) = vv; }
        }
        __syncthreads();
        f32x16 O = {};
        {
            bf16x8 qf[4];
#pragma unroll
            for (int d0 = 0; d0 < 4; ++d0) { const bf16x8 sf = *(const LAS bf16x8*)(lds + G_ST + (2 * d0 + hi) * 2048 + vrow * 16), gq = *(const LAS bf16x8*)(lds + G_QG + (2 * d0 + hi) * 1024 + icol * 16);
                O = __builtin_amdgcn_mfma_f32_32x32x16_bf16(sf, gq, O, 0, 0, 0); qf[d0] = *(const LAS bf16x8*)(lds + G_QT + (2 * d0 + hi) * 1024 + icol * 16); }
            for (int jt = 0; jt <= it; ++jt) {
                f32x16 sc = {};
#pragma unroll
                for (int d0 = 0; d0 < 4; ++d0) { const bf16x8 kf = *(const LAS bf16x8*)(lds + G_KT + (2 * d0 + hi) * 1024 + (32 * jt + r32) * 16); sc = __builtin_amdgcn_mfma_f32_32x32x16_bf16(kf, qf[d0], sc, 0, 0, 0); }
                if (jt == it) {
#pragma unroll
                    for (int r = 0; r < 16; ++r) sc[r] = (moba::crow(r, hi) > r32) ? 0.f : sc[r];
                }
                v4u pw0, pw1;
#pragma unroll
                for (int e = 0; e < 4; ++e) { pw0[e] = cvtpk(sc[2 * e], sc[2 * e + 1]); pw1[e] = cvtpk(sc[8 + 2 * e], sc[8 + 2 * e + 1]); }
                const bf16x8 v0 = trfrag(Vl + vt * 4096 + (2 * jt) * 1024), v1 = trfrag(Vl + vt * 4096 + (2 * jt + 1) * 1024);
                O = __builtin_amdgcn_mfma_f32_32x32x16_bf16(v0, __builtin_bit_cast(bf16x8, pw0), O, 0, 0, 0);
                O = __builtin_amdgcn_mfma_f32_32x32x16_bf16(v1, __builtin_bit_cast(bf16x8, pw1), O, 0, 0, 0);
            }
            float ss = 0.f;
#pragma unroll
            for (int r = 0; r < 16; ++r) ss += O[r] * O[r];
            ss += __shfl_xor(ss, 32);
            if (hi == 0) ssL[vt * 64 + icol] = ss;
        }
        {
#pragma unroll
            for (int q = 0; q < 4; ++q) { const v4f eg = *(const LAS v4f*)(eglL + 32 * it + 8 * q + 4 * hi);
#pragma unroll
                for (int e = 0; e < 4; ++e) S[4 * q + e] *= eg[e]; }
#pragma unroll
            for (int ks = 0; ks < 4; ++ks) { const bf16x8 af = trfrag(KWl + it * 4096 + ks * 1024), vf = trfrag(Vl + vt * 4096 + ks * 1024); S = __builtin_amdgcn_mfma_f32_32x32x16_bf16(af, vf, S, 0, 0, 0); }
        }
        __syncthreads();
        {
            const float rstd = __builtin_amdgcn_rsqf((ssL[icol] + ssL[64 + icol] + ssL[128 + icol] + ssL[192 + icol]) * (1.0f / 128.0f) + RMS_EPS);
            const size_t row = rowbase + t0 + icol;
#pragma unroll
            for (int q = 0; q < 4; ++q) {
                const int vc = 32 * vt + 8 * q + 4 * hi;
                const v2u gg = *(const v2u*)(U0 + row * U0P + COL_G + h * 128 + vc);
                const v4f nw = *(const v4f*)(P.gla_norm + vc);
                v2u w; w.x = cvtpk(O[4 * q] * rstd * nw.x * silu_fast(bf2f(gg.x & 0xffffu)), O[4 * q + 1] * rstd * nw.y * silu_fast(bf2f(gg.x >> 16)));
                w.y = cvtpk(O[4 * q + 2] * rstd * nw.z * silu_fast(bf2f(gg.y & 0xffffu)), O[4 * q + 3] * rstd * nw.w * silu_fast(bf2f(gg.y >> 16)));
                *(v2u*)(YG + row * 2048 + 1024 + h * 128 + vc) = w;
            }
#pragma unroll
            for (int q = 0; q < 4; ++q) { v2u w; w.x = cvtpk(S[4 * q], S[4 * q + 1]); w.y = cvtpk(S[4 * q + 2], S[4 * q + 3]); *(LAS v2u*)(lds + G_ST + (4 * it + q) * 2048 + vrow * 16 + hi * 8) = w; }
        }
    }
    __syncthreads();
}
__device__ __forceinline__ void phase(const Params& P, LAS unsigned char* lds, int G, int bx, size_t ssq_off, int roles = 3) {
    if (G == 256) {
        const int vcu = (bx % 8) * 32 + bx / 8, x = vcu >> 5, li = vcu & 31;
        if (li < 16) { if (roles & 1) ssd_unit(P, x, li, lds, ssq_off); } else if (li < 24) { if (roles & 2) gla_unit(P, x, li - 16, lds); }
    } else {
        for (int u = bx; u < 192; u += G) { if (u < 128) ssd_unit(P, u >> 4, u & 15, lds, ssq_off); else gla_unit(P, (u - 128) >> 3, (u - 128) & 7, lds); }
    }
}
}
#ifndef REP_P0
#define REP_P0 1
#endif
#ifndef REP_P1
#define REP_P1 1
#endif
#ifndef REP_P2
#define REP_P2 1
#endif
#ifndef REP_P2_ROLES
#define REP_P2_ROLES 3
#endif
#ifndef REP_P3
#define REP_P3 1
#endif
#ifndef REP_P3B
#define REP_P3B 1
#endif
#ifndef REP_P4
#define REP_P4 1
#endif
#ifndef REP_P5
#define REP_P5 1
#endif
constexpr size_t CTL_DUMMY = 512 * 1024;
constexpr int RING_BYTES = 131072, LDSCTL_OFF = RING_BYTES, MISC_OFF = LDSCTL_OFF + 320, LDS_BYTES = 147456;
__global__ void __launch_bounds__(512, 2) mk_fwd(Params P) {
    extern __shared__ __attribute__((aligned(16))) unsigned char lds_raw[];
    LAS unsigned char* lds = (LAS unsigned char*)lds_raw;
    const int G = gridDim.x, NGW = G * 8;
    volatile LAS unsigned* MISC = (volatile LAS unsigned*)(lds + MISC_OFF);
    for (int u = threadIdx.x; u < (LDS_BYTES - LDSCTL_OFF) / 4; u += 512) ((LAS unsigned*)(lds + LDSCTL_OFF))[u] = 0u;
    __syncthreads();
    unsigned char* ws = P.ws;
    XcdBarrier bar = xcd_barrier_post((unsigned*)(ws + WS_CTL + CTL_BAR), MISC + 8);
#define OPAQUE_LANE_WAVE int t_ = threadIdx.x; asm volatile("" : "+v"(t_)); const int ln = t_ & 63, wv = __builtin_amdgcn_readfirstlane(t_ >> 6)

    for (int rep = 0; rep < REP_P0; ++rep) {
        { OPAQUE_LANE_WAVE; p0_phase(P, lds, (int)blockIdx.x * 8 + wv, NGW, ln, wv); }
        xcd_barrier(bar);
    }
    for (int rep = 0; rep < REP_P1; ++rep) {
        pg8::Gemm g{(const bf16_t*)P.out, (const bf16_t*)(ws + WS_BT0), MTOK, N0, 1024, 0}; pg8::EpiU0 E{(bf16_t*)(ws + WS_U), (float*)(ws + WS_SM), -1, 0};
        pg8::StaticOrder S; S.init(MTOK, N0, G, (int)blockIdx.x);
        pg8::gemm_phase<pg8::EpiU0, pg8::StaticOrder, true, true>(lds, g, S, E);
        xcd_barrier(bar);
    }
    for (int rep = 0; rep < REP_P2; ++rep) {
        mix::phase(P, lds, G, (int)blockIdx.x, rep == 0 ? CTL_SSQ : CTL_DUMMY, rep == 0 ? 3 : REP_P2_ROLES);
        xcd_barrier(bar);
    }
    for (int rep = 0; rep < REP_P3; ++rep) {
        pg8::Gemm g{(const bf16_t*)(ws + WS_YG), (const bf16_t*)(ws + WS_BT1), MTOK, 1024, 2048, 0}; pg8::EpiRes<true> E{P.x, P.out, (const float*)(ws + WS_CTL + CTL_SSQ), 16, 0};
        pg8::StaticOrder S; S.init(MTOK, 1024, G, (int)blockIdx.x);
        pg8::gemm_phase<pg8::EpiRes<true>, pg8::StaticOrder, true, true>(lds, g, S, E);
        xcd_barrier(bar);
    }
    for (int rep = 0; rep < REP_P3B; ++rep) {
        { OPAQUE_LANE_WAVE; p3b_phase(P, lds, (int)blockIdx.x * 8 + wv, NGW, ln, wv); }
        xcd_barrier(bar);
    }
    for (int rep = 0; rep < REP_P4; ++rep) {
        pg8::Gemm g{(const bf16_t*)(ws + WS_YG), (const bf16_t*)(ws + WS_BT2), MTOK, N1, 1024, 0}; pg8::EpiU1 E{(bf16_t*)(ws + WS_U), (float*)(ws + WS_CTL + (rep == 0 ? CTL_KSUM : CTL_DUMMY)), QK_C2, -1};
        pg8::StaticOrder S; S.init(MTOK, N1, G, (int)blockIdx.x);
        pg8::gemm_phase<pg8::EpiU1, pg8::StaticOrder, true, true>(lds, g, S, E);
        xcd_barrier(bar);
    }
    for (int rep = 0; rep < REP_P5; ++rep) {
        moba::phase(P, lds, G, (int)blockIdx.x);
        xcd_barrier(bar);
    }
    { pg8::Gemm g{(const bf16_t*)(ws + WS_YG + 32 * MiB), (const bf16_t*)(ws + WS_BT3), MTOK, 1024, 1024, 0}; pg8::EpiRes<false> E{P.out, P.out, nullptr, -1, 0};
      pg8::StaticOrder S; S.init(MTOK, 1024, G, (int)blockIdx.x);
      pg8::gemm_phase<pg8::EpiRes<false>, pg8::StaticOrder, true, true>(lds, g, S, E); }
    xcd_barrier(bar);
    { OPAQUE_LANE_WAVE; for (int m = (int)blockIdx.x * 8 + wv; m < MTOK; m += NGW) rms_row_f32(P.out + (size_t)m * 1024, P.final_norm, P.out + (size_t)m * 1024, ln); }
}

extern "C" void kernel_launch(void* const* d_in, const int* in_sizes, int n_in, void* d_out, int out_size, void* d_ws, size_t ws_size, hipStream_t stream) {
    static int grid = 0;
    if (grid == 0) {
        if (n_in != 17 || in_sizes[0] != MTOK * DM || out_size != MTOK * DM || ws_size < WS_END) { fprintf(stderr, "kernel_launch: unexpected shapes (n_in %d, in0 %d, out %d, ws %zu)\n", n_in, n_in > 0 ? in_sizes[0] : -1, out_size, ws_size); grid = -1; return; }
        int dev = 0, cus = 0, per_cu = 0;
        if (hipGetDevice(&dev) != hipSuccess || hipDeviceGetAttribute(&cus, hipDeviceAttributeMultiprocessorCount, dev) != hipSuccess) { grid = -1; return; }
        if (hipFuncSetAttribute((const void*)mk_fwd, hipFuncAttributeMaxDynamicSharedMemorySize, LDS_BYTES) != hipSuccess) { fprintf(stderr, "kernel_launch: hipFuncSetAttribute failed\n"); grid = -1; return; }
        if (hipOccupancyMaxActiveBlocksPerMultiprocessor(&per_cu, (const void*)mk_fwd, 512, LDS_BYTES) != hipSuccess || per_cu < 1) { fprintf(stderr, "kernel_launch: occupancy query says %d blocks per CU\n", per_cu); }
        (void)hipGetLastError();
        grid = cus;
    }
    if (grid < 0) return;
    if (hipMemsetAsync((char*)d_ws + WS_CTL, 0, CTL_BYTES, stream) != hipSuccess) return;
    Params P{};
    const float** pp = (const float**)&P;
    for (int i = 0; i < 17; ++i) pp[i] = (const float*)d_in[i];
    P.out = (float*)d_out; P.ws = (unsigned char*)d_ws;
    hipLaunchKernelGGL(mk_fwd, dim3(grid), dim3(512), LDS_BYTES, stream, P);
}
```
